# Optimizing an MI355X kernel written in HIP

```python
import math
import jax, jax.numpy as jnp
from jax import lax
import numpy as np

D_MODEL = 1024
BATCH = 2
SEQ = 8192
DEPTH = 1

EPS = 1e-6
D_FF = 2816
N_MOD = 9
GM_CHUNK = 128
GM_WIDTH = D_MODEL
GM_GROUPS = 8
GM_GROUP_DIM = GM_WIDTH // GM_GROUPS
DN_HEADS = 8
DN_HEAD_DIM = 128
DN_WIDTH = DN_HEADS * DN_HEAD_DIM
DN_CONV = 4
DN_CHUNK = 64
N_BRANCH = 2
IN_SPLITS = (GM_WIDTH, GM_WIDTH, DN_WIDTH, DN_WIDTH, DN_WIDTH, DN_WIDTH,
             DN_HEADS, DN_HEADS, N_BRANCH * D_MODEL)
IN_WIDTH = sum(IN_SPLITS)
IN_OFFSETS = tuple(int(o) for o in np.cumsum(IN_SPLITS)[:-1])

kernel_name = "hybrid_gmlp_gdn_macaron_adaln"


def rms_norm(x, g):
    xf = x.astype(jnp.float32)
    y = xf * lax.rsqrt(jnp.mean(xf * xf, axis=-1, keepdims=True) + EPS)
    return (y * g.astype(jnp.float32)).astype(x.dtype)


def layer_norm(x, g, b):
    xf = x.astype(jnp.float32)
    mu = jnp.mean(xf, axis=-1, keepdims=True)
    var = jnp.mean(jnp.square(xf - mu), axis=-1, keepdims=True)
    y = (xf - mu) * lax.rsqrt(var + EPS)
    return (y * g.astype(jnp.float32) + b.astype(jnp.float32)).astype(x.dtype)


def modulate(h, shift, scale):
    return h * (1.0 + scale[:, None, :]) + shift[:, None, :]


def swiglu(h, w_in, w_out):
    a, b = jnp.split(h @ w_in, 2, axis=-1)
    return (jax.nn.silu(a) * b) @ w_out


def l2_normalize(x):
    return x * lax.rsqrt(jnp.sum(x * x, axis=-1, keepdims=True) + EPS)


def causal_depthwise_conv(x, w):
    ch = x.shape[-1]
    return lax.conv_general_dilated(
        x, w[:, None, :].astype(x.dtype), window_strides=(1,),
        padding=[(DN_CONV - 1, 0)], dimension_numbers=('NWC', 'WIO', 'NWC'),
        feature_group_count=ch)


def chunked_spatial_gating(u, v, ln_g, ln_b, w_s, b_s):
    bsz, seq, _ = v.shape
    v = layer_norm(v, ln_g, ln_b)
    vc = v.reshape(bsz, seq // GM_CHUNK, GM_CHUNK, GM_GROUPS, GM_GROUP_DIM)
    causal = jnp.tril(jnp.ones((GM_CHUNK, GM_CHUNK), dtype=bool))
    w = jnp.where(causal, w_s, 0.0).astype(v.dtype)
    mixed = jnp.einsum('gts,bnsgc->bntgc', w, vc) + b_s.T[:, :, None]
    return u * mixed.reshape(bsz, seq, GM_WIDTH)


def chunk_gated_delta_rule(q, k, v, g, beta):
    bsz, seq, nh, dk = q.shape
    dv = v.shape[-1]
    C = DN_CHUNK
    n_chunks = seq // C

    def chunks(t):
        return t.reshape(bsz, n_chunks, C, nh, t.shape[-1]).transpose(1, 0, 3, 2, 4)

    q, k, v = chunks(q), chunks(k), chunks(v)
    g = chunks(g[..., None])[..., 0]
    beta = chunks(beta[..., None])
    g_cum = jnp.cumsum(g, axis=-1)
    causal = jnp.tril(jnp.ones((C, C), dtype=bool))
    strict = jnp.tril(jnp.ones((C, C), dtype=bool), -1)
    decay = jnp.exp(jnp.where(causal, g_cum[..., :, None] - g_cum[..., None, :], -jnp.inf))
    k_beta = k * beta
    a_low = jnp.where(strict, jnp.einsum('nbhcd,nbhed->nbhce', k_beta, k) * decay, 0.0)
    tri = a_low + jnp.eye(C, dtype=q.dtype)
    rhs = jnp.concatenate([v * beta, k_beta * jnp.exp(g_cum)[..., None]], axis=-1)
    sol = lax.linalg.triangular_solve(tri, rhs, left_side=True, lower=True, unit_diagonal=True)
    u, w = sol[..., :dv], sol[..., dv:]
    qk = jnp.einsum('nbhcd,nbhed->nbhce', q, k) * decay
    q_dec = q * jnp.exp(g_cum)[..., None]
    k_dec = k * jnp.exp(g_cum[..., -1:] - g_cum)[..., None]
    g_last = jnp.exp(g_cum[..., -1])[..., None, None]

    def step(state, xs):
        u_n, w_n, qk_n, qd_n, kd_n, gl_n = xs
        v_new = u_n - jnp.einsum('bhck,bhkv->bhcv', w_n, state)
        o_n = (jnp.einsum('bhck,bhkv->bhcv', qd_n, state)
               + jnp.einsum('bhce,bhev->bhcv', qk_n, v_new))
        state = state * gl_n + jnp.einsum('bhck,bhcv->bhkv', kd_n, v_new)
        return state, o_n

    state0 = jnp.zeros((bsz, nh, dk, dv), q.dtype)
    _, o = lax.scan(step, state0, (u, w, qk, q_dec, k_dec, g_last))
    return o.transpose(1, 0, 3, 2, 4).reshape(bsz, seq, nh, dv)


def gated_deltanet(q, k, v, z, a, b, conv_w, a_log, dt_bias, norm_g):
    bsz, seq, _ = q.shape
    f32 = jnp.float32
    qkv = jax.nn.silu(causal_depthwise_conv(jnp.concatenate([q, k, v], axis=-1), conv_w))
    q, k, v = jnp.split(qkv, 3, axis=-1)
    shp = (bsz, seq, DN_HEADS, DN_HEAD_DIM)
    q = l2_normalize(q.reshape(shp).astype(f32)) * (DN_HEAD_DIM ** -0.5)
    k = l2_normalize(k.reshape(shp).astype(f32))
    v = v.reshape(shp).astype(f32)
    beta = jax.nn.sigmoid(b.astype(f32))
    g = -jnp.exp(a_log.astype(f32)) * jax.nn.softplus(a.astype(f32) + dt_bias.astype(f32))
    o = chunk_gated_delta_rule(q, k, v, g, beta)
    o = o * lax.rsqrt(jnp.mean(o * o, axis=-1, keepdims=True) + EPS) * norm_g.astype(f32)
    o = o * jax.nn.silu(z.reshape(shp).astype(f32))
    return o.reshape(bsz, seq, DN_WIDTH).astype(z.dtype)


def setup_inputs(seed: int = 0) -> dict:
    key = jax.random.key(seed)
    ks = iter(jax.random.split(key, 32))
    f32 = jnp.float32

    def nrm(shape, fan_in, gain=1.0):
        return jax.random.normal(next(ks), shape, f32) * (gain * fan_in ** -0.5)

    def gain_vec(shape):
        return 1.0 + 0.02 * jax.random.normal(next(ks), shape, f32)

    L = DEPTH
    x = jax.random.normal(next(ks), (BATCH, SEQ, D_MODEL), f32)
    c = jax.random.normal(next(ks), (BATCH, D_MODEL), f32)
    w_ada = nrm((L, D_MODEL, N_MOD * D_MODEL), D_MODEL, 0.5)
    b_ada = 0.01 * jax.random.normal(next(ks), (L, N_MOD * D_MODEL), f32)
    norm1_g = gain_vec((L, D_MODEL))
    ffn1_w_in = nrm((L, D_MODEL, 2 * D_FF), D_MODEL)
    ffn1_w_out = nrm((L, D_FF, D_MODEL), D_FF)
    norm2_g = gain_vec((L, D_MODEL))
    w_in = nrm((L, D_MODEL, IN_WIDTH), D_MODEL)
    conv_w = nrm((L, DN_CONV, 3 * DN_WIDTH), DN_CONV)
    a_log = jnp.log(jax.random.uniform(next(ks), (L, DN_HEADS), f32, 1.0, 16.0))
    dt = jnp.exp(jax.random.uniform(next(ks), (L, DN_HEADS), f32,
                                    math.log(1e-3), math.log(1e-1)))
    dt_bias = dt + jnp.log(-jnp.expm1(-dt))
    dn_norm_g = gain_vec((L, DN_HEAD_DIM))
    gm_ln_g = gain_vec((L, GM_WIDTH))
    gm_ln_b = 0.01 * jax.random.normal(next(ks), (L, GM_WIDTH), f32)
    gm_w_s = nrm((L, GM_GROUPS, GM_CHUNK, GM_CHUNK), GM_CHUNK)
    gm_b_s = 1.0 + 0.02 * jax.random.normal(next(ks), (L, GM_GROUPS, GM_CHUNK), f32)
    w_branch = nrm((L, N_BRANCH, GM_WIDTH, D_MODEL), GM_WIDTH)
    w_out = nrm((L, D_MODEL, D_MODEL), D_MODEL)
    norm3_g = gain_vec((L, D_MODEL))
    ffn2_w_in = nrm((L, D_MODEL, 2 * D_FF), D_MODEL)
    ffn2_w_out = nrm((L, D_FF, D_MODEL), D_FF)
    final_g = gain_vec((D_MODEL,))
    return {"x": x, "c": c, "w_ada": w_ada, "b_ada": b_ada,
            "norm1_g": norm1_g, "ffn1_w_in": ffn1_w_in, "ffn1_w_out": ffn1_w_out,
            "norm2_g": norm2_g, "w_in": w_in, "conv_w": conv_w, "a_log": a_log,
            "dt_bias": dt_bias, "dn_norm_g": dn_norm_g, "gm_ln_g": gm_ln_g,
            "gm_ln_b": gm_ln_b, "gm_w_s": gm_w_s, "gm_b_s": gm_b_s,
            "w_branch": w_branch, "w_out": w_out, "norm3_g": norm3_g,
            "ffn2_w_in": ffn2_w_in, "ffn2_w_out": ffn2_w_out, "final_g": final_g}


def reference(x, c, w_ada, b_ada, norm1_g, ffn1_w_in, ffn1_w_out, norm2_g, w_in, conv_w,
              a_log, dt_bias, dn_norm_g, gm_ln_g, gm_ln_b, gm_w_s, gm_b_s, w_branch,
              w_out, norm3_g, ffn2_w_in, ffn2_w_out, final_g):
    c_act = jax.nn.silu(c)
    for l in range(DEPTH):
        mod = c_act @ w_ada[l] + b_ada[l]
        sh1, sc1, ga1, sh2, sc2, ga2, sh3, sc3, ga3 = jnp.split(mod, N_MOD, axis=-1)

        h = modulate(rms_norm(x, norm1_g[l]), sh1, sc1)
        x = x + 0.5 * ga1[:, None, :] * swiglu(h, ffn1_w_in[l], ffn1_w_out[l])

        h = modulate(rms_norm(x, norm2_g[l]), sh2, sc2)
        proj = h @ w_in[l]
        u_a, v_a, q_b, k_b, v_b, z_b, a_b, b_b, gate_logits = jnp.split(proj, IN_OFFSETS, axis=-1)
        u_a = jax.nn.gelu(u_a, approximate=False)
        v_a = jax.nn.gelu(v_a, approximate=False)
        o_a = chunked_spatial_gating(u_a, v_a, gm_ln_g[l], gm_ln_b[l], gm_w_s[l], gm_b_s[l])
        o_b = gated_deltanet(q_b, k_b, v_b, z_b, a_b, b_b, conv_w[l], a_log[l],
                             dt_bias[l], dn_norm_g[l])
        g_a, g_b = jnp.split(jax.nn.sigmoid(gate_logits), N_BRANCH, axis=-1)
        merged = g_a * (o_a @ w_branch[l, 0]) + g_b * (o_b @ w_branch[l, 1])
        x = x + ga2[:, None, :] * (merged @ w_out[l])

        h = modulate(rms_norm(x, norm3_g[l]), sh3, sc3)
        x = x + 0.5 * ga3[:, None, :] * swiglu(h, ffn2_w_in[l], ffn2_w_out[l])
    return rms_norm(x, final_g)
```

```cpp
#include <hip/hip_runtime.h>
#include <hip/hip_cooperative_groups.h>
#include <cstdio>
#include <cstdint>
namespace pg8 {
#define PG8_LAS __attribute__((address_space(3)))
typedef unsigned short bf16_t;
typedef short bf16x8 __attribute__((ext_vector_type(8)));
typedef float f32x4 __attribute__((ext_vector_type(4)));
typedef unsigned u32x4 __attribute__((ext_vector_type(4)));
constexpr int BM = 256, BK = 64, HALF = 128, HTB = HALF * BK * 2  , STAGE_BYTES = 8 * HTB, NXCD = 8, WGM = 8;

__host__ __device__ __forceinline__ int lds_byte(int r, int c) { const int st = (r >> 4) * 2 + (c >> 5), rr = r & 15, cc = c & 31, ob = rr * 64 + cc * 2; return st * 1024 + (ob ^ (((ob >> 9) & 1) << 5)); }
__host__ __device__ __forceinline__ void stage_rc(int b, int& R, int& C) { const int st = b / 1024, sb = b % 1024, swz = sb ^ (((sb >> 9) & 1) << 5); R = (st >> 1) * 16 + swz / 64; C = (st & 1) * 32 + (swz % 64) / 2; }
__host__ __device__ __forceinline__ int perm32(int rho) { const int n = rho >> 4, i = rho & 15; return 8 * (i >> 2) + 4 * n + (i & 3); }

struct Unit { int pm, pn; };
struct Gemm { const bf16_t* A; const bf16_t* Bt; int M, N, K; };

struct StaticOrder {
    int nM, nN, nwg, G, c;
    __host__ __device__ void init(int M, int N, int G_, int c_) { nM = M / BM; nN = N / BM; nwg = nM * nN; G = G_; c = c_; }
    __host__ __device__ bool next(int i, Unit& u) const {
        const long L = (long)i * G + c; if (L >= nwg) return false;
        int wgid = (int)L; { const int q = nwg / NXCD, r = nwg % NXCD, xcd = wgid % NXCD, off = wgid / NXCD; wgid = (xcd < r ? xcd * (q + 1) : r * (q + 1) + (xcd - r) * q) + off; }
        const int nig = WGM * nN, gid = wgid / nig, fm = gid * WGM, gsz = (nM - fm) < WGM ? (nM - fm) : WGM;
        u.pm = fm + ((wgid % nig) % gsz); u.pn = (wgid % nig) / gsz; return true;
    }
    __device__ __forceinline__ void a_ready(const Unit&) const {}
    __device__ __forceinline__ void done(const Unit&) const {}
};

__device__ __forceinline__ unsigned cvt_pk_bf16(float lo, float hi) { unsigned r; asm volatile("v_cvt_pk_bf16_f32 %0, %1, %2" : "=v"(r) : "v"(lo), "v"(hi)); return r; }
typedef float f32x2 __attribute__((ext_vector_type(2)));
__device__ __forceinline__ f32x2 gelu_pk(f32x2 v) {
    const f32x2 av = __builtin_elementwise_abs(v), d = av * 0.2316418882f + 1.0f;
    f32x2 t; t.x = __builtin_amdgcn_rcpf(d.x); t.y = __builtin_amdgcn_rcpf(d.y);
    f32x2 q = t * 0.5307027145f + (-0.7265760135f); q = q * t + 0.7107068705f; q = q * t + (-0.142248368f); q = q * t + 0.127414796f; q = q * t;
    const f32x2 s = (v * v) * (-0.72134752044f);
    f32x2 e; e.x = __builtin_amdgcn_exp2f(s.x); e.y = __builtin_amdgcn_exp2f(s.y);
    const f32x2 m = v * (q * e), r = v - m;
    f32x2 o; o.x = v.x < 0.f ? m.x : r.x; o.y = v.y < 0.f ? m.y : r.y; return o;
}


__device__ __forceinline__ float silu_f(float x) { return x * __builtin_amdgcn_rcpf(1.0f + __expf(-x)); }
__device__ __forceinline__ float sigm_f(float x) { return __builtin_amdgcn_rcpf(1.0f + __expf(-x)); }
__device__ __forceinline__ u32x4 pack8(const f32x4 v0, const f32x4 v1) { u32x4 w; w.x = cvt_pk_bf16(v0[0], v0[1]); w.y = cvt_pk_bf16(v0[2], v0[3]); w.z = cvt_pk_bf16(v1[0], v1[1]); w.w = cvt_pk_bf16(v1[2], v1[3]); return w; }

struct EpiSwiglu {
    static constexpr bool PERM = true, AFTER_DRAIN = false;
    bf16_t* O; int ldo;
    __device__ __forceinline__ void operator()(const f32x4 (&acc)[2][2][4][2], const Unit& u, int wr, int wc, int fr, int fq) const {
        const int row0 = u.pm * BM + wr * 64 + fr, col0 = u.pn * HALF + wc * 32 + 8 * fq;
#pragma unroll
        for (int ai = 0; ai < 2; ++ai)
#pragma unroll
            for (int m = 0; m < 4; ++m) { bf16_t* p = O + (size_t)(row0 + ai * HALF + m * 16) * ldo + col0;
                const f32x4 a0 = acc[ai][0][m][0], a1 = acc[ai][0][m][1], b0 = acc[ai][1][m][0], b1 = acc[ai][1][m][1]; f32x4 v0, v1;
#pragma unroll
                for (int e = 0; e < 4; ++e) { v0[e] = silu_f(a0[e]) * b0[e]; v1[e] = silu_f(a1[e]) * b1[e]; }
                *(u32x4*)p = pack8(v0, v1); }
    }
};
struct EpiResid {
    static constexpr bool PERM = false, AFTER_DRAIN = false;
    const float* base; float* out; const float* coef; int coef_bstride; float scale;
    __device__ __forceinline__ void operator()(const f32x4 (&acc)[2][2][4][2], const Unit& u, int wr, int wc, int fr, int fq) const {
        const float* cf = coef + (size_t)(u.pm >> 5) * coef_bstride; const int col0 = u.pn * BM + wc * 32 + 4 * fq;
#pragma unroll
        for (int bj = 0; bj < 2; ++bj)
#pragma unroll
            for (int n = 0; n < 2; ++n) { const int c = col0 + bj * HALF + n * 16; const f32x4 cv = *(const f32x4*)(cf + c) * scale;
#pragma unroll
                for (int ai = 0; ai < 2; ++ai)
#pragma unroll
                    for (int m = 0; m < 4; ++m) { const size_t off = (size_t)(u.pm * BM + ai * HALF + wr * 64 + m * 16 + fr) * 1024 + c;
                        *(f32x4*)(out + off) = *(const f32x4*)(base + off) + cv * acc[ai][bj][m][n]; } }
    }
};
struct EpiI1 {
    static constexpr bool PERM = true, AFTER_DRAIN = false;
    bf16_t* slot0; size_t slot_stride; bf16_t* tail;
    __device__ __forceinline__ void operator()(const f32x4 (&acc)[2][2][4][2], const Unit& u, int wr, int wc, int fr, int fq) const {
        const int seg = u.pn >> 2; bf16_t* O = slot0 + (size_t)seg * slot_stride;
        const int row0 = u.pm * BM + wr * 64 + fr, col0 = (u.pn & 3) * BM + wc * 32 + 8 * fq;
#pragma unroll
        for (int ai = 0; ai < 2; ++ai)
#pragma unroll
            for (int m = 0; m < 4; ++m) { const int row = row0 + ai * HALF + m * 16;
#pragma unroll
                for (int bj = 0; bj < 2; ++bj) { f32x4 v0 = acc[ai][bj][m][0], v1 = acc[ai][bj][m][1];
#if defined(DIAG_W)
                    if (seg == 3) { float mx_ = 0.f; for (int e = 0; e < 4; ++e) mx_ = fmaxf(mx_, fmaxf(fabsf(v0[e]), fabsf(v1[e]))); atomicMax((unsigned*)((unsigned char*)tail - 236u * 1048576u) + 4011, __float_as_uint(mx_)); }
#endif
                    if (seg == 3) {
#pragma unroll
                        for (int e = 0; e < 4; ++e) { v0[e] = silu_f(v0[e]); v1[e] = silu_f(v1[e]); } }
                    const u32x4 w = pack8(v0, v1);
                    *(u32x4*)(O + (size_t)row * 1024 + col0 + bj * HALF) = w;
                    } }
    }
};
struct EpiI2 {
    static constexpr bool PERM = true, AFTER_DRAIN = false;
    bf16_t* s0; bf16_t* s1; bf16_t* s2; bf16_t* s3; bf16_t* s4; float* stats;
    __device__ __forceinline__ void operator()(const f32x4 (&acc)[2][2][4][2], const Unit& u, int wr, int wc, int fr, int fq) const {
        const int seg = u.pn >> 2; bf16_t* O = seg == 0 ? s0 : (seg == 1 ? s1 : (seg == 2 ? s2 : (seg == 3 ? s3 : s4)));
        const int row0 = u.pm * BM + wr * 64 + fr, col0 = (u.pn & 3) * BM + wc * 32 + 8 * fq;
#pragma unroll
        for (int ai = 0; ai < 2; ++ai)
#pragma unroll
            for (int m = 0; m < 4; ++m) { const int row = row0 + ai * HALF + m * 16; float rs[2] = {0.f, 0.f}, rq[2] = {0.f, 0.f};
#pragma unroll
                for (int bj = 0; bj < 2; ++bj) { f32x4 v0 = acc[ai][bj][m][0], v1 = acc[ai][bj][m][1];
                    if (seg < 2) { const f32x2 a = gelu_pk((f32x2){v0[0], v0[1]}), b = gelu_pk((f32x2){v0[2], v0[3]}), c = gelu_pk((f32x2){v1[0], v1[1]}), d = gelu_pk((f32x2){v1[2], v1[3]});
                        v0 = (f32x4){a.x, a.y, b.x, b.y}; v1 = (f32x4){c.x, c.y, d.x, d.y};
                        if (seg == 1) { rs[bj] = (v0[0] + v0[1]) + (v0[2] + v0[3]) + (v1[0] + v1[1]) + (v1[2] + v1[3]);
                            rq[bj] = (v0[0] * v0[0] + v0[1] * v0[1]) + (v0[2] * v0[2] + v0[3] * v0[3]) + (v1[0] * v1[0] + v1[1] * v1[1]) + (v1[2] * v1[2] + v1[3] * v1[3]); } }
                    else if (seg < 4) {
#pragma unroll
                        for (int e = 0; e < 4; ++e) { v0[e] = sigm_f(v0[e]); v1[e] = sigm_f(v1[e]); } }
                    else {
#pragma unroll
                        for (int e = 0; e < 4; ++e) { v0[e] = silu_f(v0[e]); v1[e] = silu_f(v1[e]); } }
                    *(u32x4*)(O + (size_t)row * 1024 + col0 + bj * HALF) = pack8(v0, v1); }
                if (seg == 1) { float s = rs[0] + rs[1], q = rq[0] + rq[1]; s += __shfl_xor(s, 16); s += __shfl_xor(s, 32); q += __shfl_xor(q, 16); q += __shfl_xor(q, 32);
                    if (fq == 0) { atomicAdd(stats + (size_t)row * 2, s); atomicAdd(stats + (size_t)row * 2 + 1, q); } } }
    }
};
struct ZOrder {
    int G, c;
    __device__ bool next(int i, Unit& u) const { const int Lz = i * G + c; if (Lz >= 256) return false; u.pm = Lz >> 2; u.pn = Lz & 3; return true; }
    __device__ __forceinline__ void a_ready(const Unit&) const {}
    __device__ __forceinline__ void done(const Unit&) const {}
};
struct EpiZ {
    static constexpr bool PERM = true, AFTER_DRAIN = false;
    bf16_t* O;
    __device__ __forceinline__ void operator()(const f32x4 (&acc)[2][2][4][2], const Unit& u, int wr, int wc, int fr, int fq) const {
        const int row0 = u.pm * BM + wr * 64 + fr, col0 = u.pn * BM + wc * 32 + 8 * fq;
#pragma unroll
        for (int ai = 0; ai < 2; ++ai)
#pragma unroll
            for (int m = 0; m < 4; ++m) { const int row = row0 + ai * HALF + m * 16;
#pragma unroll
                for (int bj = 0; bj < 2; ++bj) { f32x4 v0 = acc[ai][bj][m][0], v1 = acc[ai][bj][m][1];
#pragma unroll
                    for (int e = 0; e < 4; ++e) { v0[e] = silu_f(v0[e]); v1[e] = silu_f(v1[e]); }
                    *(u32x4*)(O + (size_t)row * 1024 + col0 + bj * HALF) = pack8(v0, v1); } }
    }
};
struct BranchOrder {
    StaticOrder so;
    __device__ bool next(int i, Unit& u) const { Unit t; if (!so.next(i >> 1, t)) return false; const int which = i & 1; u.pm = t.pm + which * 192; u.pn = t.pn + which * 4; return true; }
    __device__ __forceinline__ void a_ready(const Unit&) const {}
    __device__ __forceinline__ void done(const Unit&) const {}
};
struct EpiBranch {
    static constexpr bool PERM = true, AFTER_DRAIN = false;
    const bf16_t* ga; const bf16_t* gb; bf16_t* merged;
    __device__ __forceinline__ void operator()(const f32x4 (&acc)[2][2][4][2], const Unit& u, int wr, int wc, int fr, int fq) const {
        const int which = u.pm >= 64 ? 1 : 0; const int pm = u.pm - which * 192, pn = u.pn - which * 4; const bf16_t* gt = which ? gb : ga;
        const int row0 = pm * BM + wr * 64 + fr, col0 = pn * BM + wc * 32 + 8 * fq;
#pragma unroll
        for (int ai = 0; ai < 2; ++ai)
#pragma unroll
            for (int m = 0; m < 4; ++m) { const int row = row0 + ai * HALF + m * 16;
#pragma unroll
                for (int bj = 0; bj < 2; ++bj) { const size_t off = (size_t)row * 1024 + col0 + bj * HALF;
                    const u32x4 g = *(const u32x4*)(gt + off); f32x4 v0 = acc[ai][bj][m][0], v1 = acc[ai][bj][m][1];
                    v0[0] *= __uint_as_float(g.x << 16); v0[1] *= __uint_as_float(g.x & 0xffff0000u); v0[2] *= __uint_as_float(g.y << 16); v0[3] *= __uint_as_float(g.y & 0xffff0000u);
                    v1[0] *= __uint_as_float(g.z << 16); v1[1] *= __uint_as_float(g.z & 0xffff0000u); v1[2] *= __uint_as_float(g.w << 16); v1[3] *= __uint_as_float(g.w & 0xffff0000u);
#if defined(ZERO_A)
                    if (!which) { v0 = (f32x4){0.f, 0.f, 0.f, 0.f}; v1 = v0; }
#endif
#if defined(ZERO_B)
                    if (which) { v0 = (f32x4){0.f, 0.f, 0.f, 0.f}; v1 = v0; }
#endif
                    if (which) { unsigned* mp = (unsigned*)(merged + off); u32x4 p;
                        p.x = __hip_atomic_load(mp + 0, __ATOMIC_RELAXED, __HIP_MEMORY_SCOPE_AGENT); p.y = __hip_atomic_load(mp + 1, __ATOMIC_RELAXED, __HIP_MEMORY_SCOPE_AGENT);
                        p.z = __hip_atomic_load(mp + 2, __ATOMIC_RELAXED, __HIP_MEMORY_SCOPE_AGENT); p.w = __hip_atomic_load(mp + 3, __ATOMIC_RELAXED, __HIP_MEMORY_SCOPE_AGENT);
                        v0[0] += __uint_as_float(p.x << 16); v0[1] += __uint_as_float(p.x & 0xffff0000u); v0[2] += __uint_as_float(p.y << 16); v0[3] += __uint_as_float(p.y & 0xffff0000u);
                        v1[0] += __uint_as_float(p.z << 16); v1[1] += __uint_as_float(p.z & 0xffff0000u); v1[2] += __uint_as_float(p.w << 16); v1[3] += __uint_as_float(p.w & 0xffff0000u); }
                    *(u32x4*)(merged + off) = pack8(v0, v1); } }
    }
};

template <class Epi, class Sched, bool ALIGN_EPI = false, bool SP2 = false>
__device__ __forceinline__ void gemm_phase(PG8_LAS unsigned char* lds, const Gemm g, const Sched& S, const Epi& E) {
    const int tid = threadIdx.x, wid = __builtin_amdgcn_readfirstlane(tid >> 6), lane = tid & 63, wr = wid >> 2, wc = wid & 3, fr = lane & 15, fq = lane >> 4;
    const int K = g.K, nt = K / BK;
    unsigned voffA[2], voffB[2];
#pragma unroll
    for (int i = 0; i < 2; ++i) { int R, C; stage_rc(tid * 16 + i * 8192, R, C); const int Rb = Epi::PERM ? ((R & ~31) + perm32(R & 31)) : R;
        voffA[i] = (unsigned)(R * K + C) * 2u; voffB[i] = (unsigned)(Rb * K + C) * 2u; }
    const size_t kstep = (size_t)(BK * 2);
    const size_t hstep = (size_t)HALF * K * 2;
    const size_t tstep = 2 * hstep;
    const unsigned ldsw = (unsigned)wid * 1024u;
    const int aoff = lds_byte(wr * 64 + fr, fq * 8), boff = lds_byte(wc * 32 + fr, fq * 8);
#define PG8_SA(b, h) (((b) * 2 + (h)) * HTB)
#define PG8_SB(b, h) ((4 + (b) * 2 + (h)) * HTB)
#define PG8_STAGE(bufoff, gbase, voff) do { _Pragma("unroll") for (int _i = 0; _i < 2; ++_i) \
        __builtin_amdgcn_global_load_lds((const unsigned*)((const char*)(gbase) + (voff)[_i]), (PG8_LAS unsigned*)(lds + (bufoff) + ldsw + _i * 8192), 16, 0, 0); } while (0)
#define PG8_LDA(dst, b, h) do { _Pragma("unroll") for (int m = 0; m < 4; ++m) _Pragma("unroll") for (int k = 0; k < 2; ++k) dst[m][k] = *(const PG8_LAS bf16x8*)(lds + PG8_SA(b, h) + aoff + m * 2048 + k * 1024); } while (0)
#define PG8_LDB(dst, b, h) do { _Pragma("unroll") for (int n = 0; n < 2; ++n) _Pragma("unroll") for (int k = 0; k < 2; ++k) dst[n][k] = *(const PG8_LAS bf16x8*)(lds + PG8_SB(b, h) + boff + n * 2048 + k * 1024); } while (0)
#define PG8_MMA(ai, bj, At, Bt) do { __builtin_amdgcn_s_setprio(1); _Pragma("unroll") for (int m = 0; m < 4; ++m) _Pragma("unroll") for (int n = 0; n < 2; ++n) _Pragma("unroll") for (int k = 0; k < 2; ++k) \
        acc[ai][bj][m][n] = __builtin_amdgcn_mfma_f32_16x16x32_bf16(Bt[n][k], At[m][k], acc[ai][bj][m][n], 0, 0, 0); __builtin_amdgcn_s_setprio(0); } while (0)
#define PG8_WAIT_V(n) asm volatile("s_waitcnt vmcnt(" #n ")" ::: "memory")
#define PG8_WAIT_L(n) asm volatile("s_waitcnt lgkmcnt(" #n ")" ::: "memory")
#define PG8_BAR __builtin_amdgcn_s_barrier()
#define PG8_SCHED __builtin_amdgcn_sched_barrier(0)
    Unit cur, nxt; int ui = 0;
    if (!S.next(0, cur)) return;
    f32x4 acc[2][2][4][2];
#pragma unroll
    for (int a = 0; a < 2; ++a)
#pragma unroll
        for (int b = 0; b < 2; ++b)
#pragma unroll
            for (int m = 0; m < 4; ++m)
#pragma unroll
                for (int n = 0; n < 2; ++n) acc[a][b][m][n] = (f32x4){0.f, 0.f, 0.f, 0.f};
    bf16x8 At[4][2], B0[2][2], B1[2][2];
    const char* cA = (const char*)g.A + (size_t)cur.pm * tstep; const char* cB = (const char*)g.Bt + (size_t)cur.pn * tstep;
    S.a_ready(cur);
    if constexpr (SP2) {
        PG8_STAGE(PG8_SB(0, 0), cB, voffB); PG8_STAGE(PG8_SB(0, 1), cB + hstep, voffB); PG8_STAGE(PG8_SA(0, 0), cA, voffA); PG8_STAGE(PG8_SA(0, 1), cA + hstep, voffA);
        if (wr == 1) PG8_BAR;
        PG8_WAIT_V(2); PG8_BAR;
        PG8_STAGE(PG8_SB(1, 0), cB + kstep, voffB); PG8_STAGE(PG8_SA(1, 0), cA + kstep, voffA); PG8_STAGE(PG8_SB(1, 1), cB + hstep + kstep, voffB);
        PG8_WAIT_V(6); PG8_BAR;
    } else {
        PG8_STAGE(PG8_SB(0, 0), cB, voffB); PG8_STAGE(PG8_SA(0, 0), cA, voffA); PG8_STAGE(PG8_SB(0, 1), cB + hstep, voffB); PG8_STAGE(PG8_SA(0, 1), cA + hstep, voffA);
        if (wr == 1) PG8_BAR;
        PG8_WAIT_V(4); PG8_BAR;
        PG8_STAGE(PG8_SB(1, 0), cB + kstep, voffB); PG8_STAGE(PG8_SA(1, 0), cA + kstep, voffA); PG8_STAGE(PG8_SB(1, 1), cB + hstep + kstep, voffB);
        PG8_WAIT_V(6); PG8_BAR;
    }
    for (;;) {
        const bool has_next = S.next(ui + 1, nxt);
        const char* nA = has_next ? (const char*)g.A + (size_t)nxt.pm * tstep : cA; const char* nB = has_next ? (const char*)g.Bt + (size_t)nxt.pn * tstep : cB;
        for (int t = 0; t < nt; t += 2) {
            const bool last = (t == nt - 2);
            const char* a1 = cA + (size_t)(t + 1) * kstep;
            const char* a2 = last ? nA : cA + (size_t)(t + 2) * kstep; const char* b2 = last ? nB : cB + (size_t)(t + 2) * kstep;
            const char* a3 = a2 + kstep; const char* b3 = b2 + kstep;
            if (last && has_next) S.a_ready(nxt);
            if constexpr (SP2) {
            PG8_LDB(B0, 0, 0); PG8_LDB(B1, 0, 1); PG8_SCHED; PG8_LDA(At, 0, 0); PG8_STAGE(PG8_SA(1, 1), a1 + hstep, voffA);
            PG8_WAIT_V(8); PG8_WAIT_L(0); PG8_BAR; PG8_MMA(0, 0, At, B0); PG8_MMA(0, 1, At, B1); PG8_BAR; PG8_SCHED;
            PG8_LDA(At, 0, 1); PG8_STAGE(PG8_SB(0, 0), b2, voffB); PG8_STAGE(PG8_SB(0, 1), b2 + hstep, voffB); PG8_STAGE(PG8_SA(0, 0), a2, voffA);
            PG8_WAIT_V(8); PG8_WAIT_L(0); PG8_BAR; PG8_MMA(1, 0, At, B0); PG8_MMA(1, 1, At, B1); PG8_BAR; PG8_SCHED;
            PG8_LDB(B0, 1, 0); PG8_LDB(B1, 1, 1); PG8_SCHED; PG8_LDA(At, 1, 0); PG8_STAGE(PG8_SA(0, 1), a2 + hstep, voffA);
            PG8_WAIT_V(8); PG8_WAIT_L(0); PG8_BAR; PG8_MMA(0, 0, At, B0); PG8_MMA(0, 1, At, B1); PG8_BAR; PG8_SCHED;
            PG8_LDA(At, 1, 1); PG8_STAGE(PG8_SB(1, 0), b3, voffB); PG8_STAGE(PG8_SB(1, 1), b3 + hstep, voffB); PG8_STAGE(PG8_SA(1, 0), a3, voffA);
            PG8_WAIT_V(8); PG8_WAIT_L(0); PG8_BAR; PG8_MMA(1, 0, At, B0); PG8_MMA(1, 1, At, B1); PG8_BAR; PG8_SCHED;
            } else {
            PG8_LDB(B0, 0, 0); PG8_SCHED; PG8_LDA(At, 0, 0); PG8_STAGE(PG8_SA(1, 1), a1 + hstep, voffA);
            PG8_WAIT_L(8); PG8_BAR; PG8_WAIT_L(0); PG8_MMA(0, 0, At, B0); PG8_BAR; PG8_SCHED;
            PG8_LDB(B1, 0, 1); PG8_STAGE(PG8_SB(0, 0), b2, voffB);
            PG8_BAR; PG8_WAIT_L(0); PG8_MMA(0, 1, At, B1); PG8_BAR;
            PG8_LDA(At, 0, 1); PG8_STAGE(PG8_SA(0, 0), a2, voffA);
            PG8_BAR; PG8_WAIT_L(0); PG8_MMA(1, 0, At, B0); PG8_BAR; PG8_SCHED;
            PG8_STAGE(PG8_SB(0, 1), b2 + hstep, voffB);
            PG8_WAIT_V(6); PG8_BAR; PG8_MMA(1, 1, At, B1); PG8_BAR;
            PG8_LDB(B0, 1, 0); PG8_SCHED; PG8_LDA(At, 1, 0); PG8_STAGE(PG8_SA(0, 1), a2 + hstep, voffA);
            PG8_WAIT_L(8); PG8_BAR; PG8_WAIT_L(0); PG8_MMA(0, 0, At, B0); PG8_BAR; PG8_SCHED;
            PG8_LDB(B1, 1, 1); PG8_STAGE(PG8_SB(1, 0), b3, voffB);
            PG8_BAR; PG8_WAIT_L(0); PG8_MMA(0, 1, At, B1); PG8_BAR;
            PG8_LDA(At, 1, 1); PG8_STAGE(PG8_SA(1, 0), a3, voffA);
            PG8_BAR; PG8_WAIT_L(0); PG8_MMA(1, 0, At, B0); PG8_BAR; PG8_SCHED;
            PG8_STAGE(PG8_SB(1, 1), b3 + hstep, voffB);
            PG8_WAIT_V(6); PG8_BAR; PG8_MMA(1, 1, At, B1); PG8_BAR;
            }
        }
        if constexpr (ALIGN_EPI) { if (wr == 0) PG8_BAR; }
        if constexpr (!Epi::AFTER_DRAIN) { E(acc, cur, wr, wc, fr, fq); S.done(cur); }
        if (!has_next) break;
#pragma unroll
        for (int a = 0; a < 2; ++a)
#pragma unroll
            for (int b = 0; b < 2; ++b)
#pragma unroll
                for (int m = 0; m < 4; ++m)
#pragma unroll
                    for (int n = 0; n < 2; ++n) acc[a][b][m][n] = (f32x4){0.f, 0.f, 0.f, 0.f};
        cur = nxt; cA = nA; cB = nB; ++ui;
        if constexpr (ALIGN_EPI) { if (wr == 1) PG8_BAR; }
    }
    PG8_WAIT_V(0);
    if constexpr (!ALIGN_EPI) { if (wr == 0) PG8_BAR; }
    PG8_BAR;
    if constexpr (Epi::AFTER_DRAIN) { E.fused(acc, cur, wr, wc, fr, fq, lds, wid, lane); S.done(cur); }
#undef PG8_SA
#undef PG8_SB
#undef PG8_STAGE
#undef PG8_LDA
#undef PG8_LDB
#undef PG8_MMA
#undef PG8_WAIT_V
#undef PG8_WAIT_L
#undef PG8_BAR
#undef PG8_SCHED
}
}

namespace cg = cooperative_groups;
#define LAS __attribute__((address_space(3)))
typedef unsigned short bf16;
typedef unsigned v4u __attribute__((ext_vector_type(4)));
typedef unsigned v2u __attribute__((ext_vector_type(2)));
typedef float f32x4 __attribute__((ext_vector_type(4)));
typedef short bf16x8 __attribute__((ext_vector_type(8)));
using pg8::cvt_pk_bf16;
typedef float f32x2_t __attribute__((ext_vector_type(2)));
typedef __bf16 bf16x2_t __attribute__((ext_vector_type(2)));
__device__ __forceinline__ unsigned pkc(float lo, float hi) { const f32x2_t v = {lo, hi}; return __builtin_bit_cast(unsigned, __builtin_convertvector(v, bf16x2_t)); }

constexpr int NB = 2, SEQ = 8192, D = 1024, M = NB * SEQ, FF = 2816, NH = 8, NMOD = 9 * D, INW = 8208;
constexpr float EPS = 1e-6f;
constexpr size_t MiB = 1u << 20;
constexpr size_t WS_MOD = 64 * 1024;
constexpr size_t WS_GL = 256 * 1024;
constexpr size_t WS_STATS = 512 * 1024;
constexpr size_t WS_G = 2 * MiB;
constexpr size_t WS_BETA = 1 * MiB + 512 * 1024;
constexpr size_t WS_W = 4 * MiB;
constexpr size_t WS_WBR = 21 * MiB, WS_WOUT = 25 * MiB;
constexpr size_t WS_H = 28 * MiB;
constexpr size_t WS_Q = 60 * MiB, WS_K = 92 * MiB, WS_V = 124 * MiB, WS_Z = 156 * MiB, WS_WW = 188 * MiB, WS_QK = 220 * MiB, WS_TAIL = 156 * MiB;
constexpr size_t WS_ACT = 60 * MiB;
constexpr size_t WS_END = 256 * MiB;
constexpr int LDS_BYTES = 160 * 1024;
#if defined(SKIP_F1)
constexpr float F1SCALE = 0.0f;
#else
constexpr float F1SCALE = 0.5f;
#endif

__device__ __forceinline__ float bf2f(unsigned short h) { return __uint_as_float((unsigned)h << 16); }
__device__ __forceinline__ float wave_sum(float v) {
#pragma unroll
    for (int o = 1; o < 64; o <<= 1) v += __shfl_xor(v, o);
    return v;
}
#define LDS_WAIT() asm volatile("s_waitcnt lgkmcnt(0)" ::: "memory")
#define WG_BAR() do { asm volatile("s_waitcnt lgkmcnt(0)" ::: "memory"); __builtin_amdgcn_s_barrier(); asm volatile("" ::: "memory"); } while (0)


#define RLX_AGENT __ATOMIC_RELAXED, __HIP_MEMORY_SCOPE_AGENT
#define XB_TMO      128
#define XB_XCNT(j)  (256  + 64 * (j))
#define XB_XSUB(j)  (1280 + 64 * (j))
#define XB_XGEN(j)  (2304 + 64 * (j))
#define XB_TOP      3328
#define XB_TOPGEN   3392
#define XCD_BAR_WORDS 3456
#define XB_SPIN_CAP (1u << 18)

__device__ __forceinline__ unsigned xb_ld(unsigned* p)              { return __hip_atomic_load(p, __ATOMIC_RELAXED, __HIP_MEMORY_SCOPE_AGENT); }
__device__ __forceinline__ unsigned xb_add(unsigned* p, unsigned v) { return __hip_atomic_fetch_add(p, v, __ATOMIC_RELAXED, __HIP_MEMORY_SCOPE_AGENT); }
__device__ __forceinline__ unsigned xb_xcc_id() { return (unsigned)__builtin_amdgcn_s_getreg((3 << 11) | 20) & 0xFu; }
#define XB_SPIN(cond, bar) do { unsigned _sp = 0; while (cond) { __builtin_amdgcn_s_sleep(1); \
    if ((++_sp & 255u) == 0u) { if (xb_ld(&(bar)[XB_TMO])) break; if (_sp > XB_SPIN_CAP) { atomicAdd(&(bar)[XB_TMO], 1u); break; } } } } while (0)

struct XcdBarrier {
    unsigned* bar; unsigned x;
    volatile LAS unsigned* st;
};

__device__ __forceinline__ XcdBarrier xcd_barrier_post(unsigned* bar, volatile LAS unsigned* st) {
    XcdBarrier b; b.bar = bar; b.x = xb_xcc_id(); b.st = st;
    if (threadIdx.x == 0) (void)xb_add(&bar[XB_XCNT(b.x)], 1u);
    return b;
}
__device__ __forceinline__ void xcd_barrier_complete(unsigned* bar, unsigned x, unsigned& nloc, unsigned& nx) {
    const unsigned G = gridDim.x * gridDim.y * gridDim.z;
    unsigned sum, cnt, mine, sp = 0u;
    for (;;) {
        sum = 0u; cnt = 0u; mine = 0u;
#pragma unroll
        for (unsigned j = 0; j < 16; ++j) { const unsigned c = xb_ld(&bar[XB_XCNT(j)]); sum += c; cnt += (c > 0u) ? 1u : 0u; mine = (j == x) ? c : mine; }
        if (sum == G) break;
        __builtin_amdgcn_s_sleep(1);
        if ((++sp & 255u) == 0u) { if (xb_ld(&bar[XB_TMO])) break; if (sp > XB_SPIN_CAP) { atomicAdd(&bar[XB_TMO], 1u); break; } }
    }
    nloc = mine > 0u ? mine : 1u; nx = cnt > 0u ? cnt : 1u;
}

__device__ __forceinline__ void xcd_barrier(const XcdBarrier& b) {
    asm volatile("s_waitcnt vmcnt(0)" ::: "memory");
    __syncthreads();
    if (threadIdx.x == 0) {
        unsigned* bar = b.bar;
        __builtin_amdgcn_s_waitcnt(0);
        unsigned nloc = b.st[0], nx = b.st[1];
        if (nloc == 0u) { xcd_barrier_complete(bar, b.x, nloc, nx); b.st[0] = nloc; b.st[1] = nx; }
        const unsigned old = xb_add(&bar[XB_XSUB(b.x)], 1u);
        const unsigned gen = old / nloc;
        if (old + 1u == (gen + 1u) * nloc) {
            __builtin_amdgcn_fence(__ATOMIC_RELEASE, "agent");
            asm volatile("s_waitcnt vmcnt(0)" ::: "memory");
            const unsigned og = xb_add(&bar[XB_TOP], 1u);
            const unsigned tg = og / nx;
            if (og + 1u == (tg + 1u) * nx) xb_add(&bar[XB_TOPGEN], 1u);
            else XB_SPIN(xb_ld(&bar[XB_TOPGEN]) == tg, bar);
            __builtin_amdgcn_fence(__ATOMIC_ACQUIRE, "agent");
            xb_add(&bar[XB_XGEN(b.x)], 1u);
            asm volatile("s_waitcnt vmcnt(0)" ::: "memory");
        } else {
            XB_SPIN(xb_ld(&bar[XB_XGEN(b.x)]) == gen, bar);
            __builtin_amdgcn_fence(__ATOMIC_ACQUIRE, "agent");
            asm volatile("s_waitcnt vmcnt(0)" ::: "memory");
        }
    }
    __syncthreads();
}

__device__ __forceinline__ void tr_tile(const float* W, int ldw, int k0, int ns0, bf16* WT, int K, int nd0, LAS float* scr, int lane) {
#pragma unroll 8
    for (int i = 0; i < 32; ++i) { const int kk = 2 * i + (lane >> 5); scr[kk * 33 + (lane & 31)] = W[(size_t)(k0 + kk) * ldw + ns0 + (lane & 31)]; }
    LDS_WAIT(); asm volatile("" ::: "memory");
    const int c = lane & 7;
#pragma unroll
    for (int j = 0; j < 4; ++j) { const int n = (lane >> 3) + 8 * j; const LAS float* s = scr + (8 * c) * 33 + n;
        v4u o; o.x = cvt_pk_bf16(s[0 * 33], s[1 * 33]); o.y = cvt_pk_bf16(s[2 * 33], s[3 * 33]); o.z = cvt_pk_bf16(s[4 * 33], s[5 * 33]); o.w = cvt_pk_bf16(s[6 * 33], s[7 * 33]);
        *(v4u*)(WT + (size_t)(nd0 + n) * K + k0 + 8 * c) = o; }
    LDS_WAIT(); asm volatile("" ::: "memory");
}
__device__ __forceinline__ void conv_ffn_in(const float* W, bf16* WT, int item, LAS float* scr, int lane) {
    const int kb = item / 176, nb = item % 176, c = 32 * nb; const int half = c >= FF ? 1 : 0, j = c - half * FF;
    tr_tile(W, 2 * FF, 64 * kb, c, WT, D, 256 * (j >> 7) + 128 * half + (j & 127), scr, lane);
}
__device__ __forceinline__ void conv_plain(const float* W, int Kdim, int Ndim, bf16* WT, int item, LAS float* scr, int lane) {
    const int nblk = Ndim / 32, kb = item / nblk, nb = item % nblk;
    tr_tile(W, Ndim, 64 * kb, 32 * nb, WT, Kdim, 32 * nb, scr, lane);
}
__device__ __forceinline__ void conv_inproj(const float* W, bf16* WT, int item, LAS float* scr, int lane) {
    const int kb = item >> 8, nd0 = 32 * (item & 255); const int ns0 = nd0 < 3072 ? nd0 + 2048 : (nd0 < 5120 ? nd0 - 3072 : (nd0 < 7168 ? nd0 + 1040 : nd0 - 2048));
    tr_tile(W, INW, 64 * kb, ns0, WT, D, nd0, scr, lane);
}

template <int MODE>
__device__ __forceinline__ void norm_rows(const float* xin, const float* gain, const float* mod, int sh_off, int sc_off, bf16* H, int gw, int NGW, int lane,
                                          const LAS float* wabT, const float* a_log, const float* dt_bias, float* Gd, float* Bd) {
    int curb = -1; f32x4 cA[4], cB[4];
    for (int m = gw; m < M; m += NGW) {
        const int b = m >> 13;
        if (b != curb) { curb = b;
#pragma unroll
            for (int j = 0; j < 4; ++j) { const int c = 4 * lane + 256 * j; const f32x4 gv = *(const f32x4*)(gain + c), sc = *(const f32x4*)(mod + b * NMOD + sc_off + c);
                cA[j] = gv * (sc + 1.0f); cB[j] = *(const f32x4*)(mod + b * NMOD + sh_off + c); } }
        const f32x4* xr = (const f32x4*)(xin + (size_t)m * D) + lane; f32x4 v[4]; float ss = 0.f;
#pragma unroll
        for (int j = 0; j < 4; ++j) { v[j] = xr[64 * j]; ss += (v[j].x * v[j].x + v[j].y * v[j].y) + (v[j].z * v[j].z + v[j].w * v[j].w); }
        const float r = 1.0f / sqrtf(wave_sum(ss) * (1.0f / D) + EPS);
        v2u* o8 = (v2u*)(H + (size_t)m * D) + lane;
#pragma unroll
        for (int j = 0; j < 4; ++j) { v[j] = v[j] * r * cA[j] + cB[j]; v2u w; w.x = cvt_pk_bf16(v[j].x, v[j].y); w.y = cvt_pk_bf16(v[j].z, v[j].w); o8[64 * j] = w; }
        if (MODE == 1) {
            float mine = 0.f;
            LAS float* red = (LAS float*)((LAS unsigned char*)wabT + 65536) + (lane * 0 + __builtin_amdgcn_readfirstlane(threadIdx.x >> 6)) * 1040;
#pragma unroll
            for (int c = 0; c < 16; ++c) { float a = 0.f;
#pragma unroll
                for (int j = 0; j < 4; ++j) { const f32x4 w = *(const LAS f32x4*)(wabT + c * 1024 + 4 * lane + 256 * j); a += (v[j].x * w.x + v[j].y * w.y) + (v[j].z * w.z + v[j].w * w.w); }
                red[c * 65 + lane] = a; }
            asm volatile("s_waitcnt lgkmcnt(0)" ::: "memory");
            if (lane < 16) { float s0 = 0.f, s1 = 0.f, s2 = 0.f, s3 = 0.f;
#pragma unroll
                for (int j = 0; j < 64; j += 4) { s0 += red[lane * 65 + j]; s1 += red[lane * 65 + j + 1]; s2 += red[lane * 65 + j + 2]; s3 += red[lane * 65 + j + 3]; }
                mine = (s0 + s1) + (s2 + s3); }
            asm volatile("s_waitcnt lgkmcnt(0)" ::: "memory");
            { const int hh = lane & 7; const float xv = mine + dt_bias[hh]; const float sp = fmaxf(xv, 0.f) + log1pf(__expf(-fabsf(xv)));
              const float gval = -__expf(a_log[hh]) * sp, bval = 1.0f / (1.0f + __expf(-mine));
              if (lane < 16) Gd[(size_t)m * 16 + lane] = (lane < 8) ? gval : bval; }
        }
    }
}


#if defined(DIAG_W)
__device__ __forceinline__ void zprobe(const bf16* Vs_, size_t tok0, int h, int ht, int lane, unsigned* word) {
    if (ht < 64) { float m = fabsf(bf2f(Vs_[16777216 + (tok0 + ht) * 1024 + h * 128 + 5]));
        for (int o = 1; o < 64; o <<= 1) m = fmaxf(m, __shfl_xor(m, o));
        if (lane == 0) atomicMax(word, __float_as_uint(1.0f / (m + 1e-6f))); }
}
#endif
#if defined(NO_TAIL)
#define NOTAIL_FLAG false
#else
#define NOTAIL_FLAG true
#endif
constexpr int DL_HALF = 69632;
template <int MODE>
__device__ __forceinline__ void dn_local_phase(LAS unsigned char* L, bf16* Qs, bf16* Ks, bf16* Vs, bf16* WWs, bf16* QKs, bf16* Qp, const float* Gd, const float* Bd, float* GL,
                                               const float* conv_w, int tid, int nblk, int bid) {
    const int wv = __builtin_amdgcn_readfirstlane((tid >> 6) & 3);
    for (int it = bid; it < 1024; it += nblk) {
        int tidv = tid; asm volatile("" : "+v"(tidv));
        const int hw = tidv >> 8, ht = tidv & 255, lane = tidv & 63, fr = lane & 15, fq = lane >> 4;
        LAS unsigned char* Lh = L + hw * DL_HALF;
        LAS float* AM = (LAS float*)(Lh + 52224);
        LAS float* gcs = (LAS float*)(Lh + 68608); LAS float* bts = gcs + 64; LAS float* egs = gcs + 128; LAS float* gcs2 = gcs + 192;
        LAS float* cwl = (LAS float*)(L + 2 * DL_HALF + hw * 6144);
        const int unit = it * 2 + hw, h = unit & 7, n = (unit >> 3) & 127, b = unit >> 10;
        const size_t tok0 = (size_t)b * SEQ + 64 * n;
        __syncthreads();
        if (MODE == 0) {
#pragma unroll
            for (int k12 = 0; k12 < 12; ++k12) { const int idx = ht + 256 * k12, T = idx >> 10, r = (idx >> 4) & 63, ch = idx & 15;
                const bf16* sp = (T == 0 ? Qs : (T == 1 ? Ks : Vs)) + (tok0 + r) * 1024 + h * 128 + ch * 8;
                *(LAS v4u*)(Lh + T * 18224 + (r + 3) * 272 + ch * 16) = *(const v4u*)sp; }
            if (ht < 144) { const int T = ht / 48, rem = ht - T * 48, r = rem >> 4, ch = rem & 15;
                v4u val = (v4u){0u, 0u, 0u, 0u};
#if !defined(NO_HALO)
                if (n > 0) val = *(const v4u*)((T == 0 ? Qs : (T == 1 ? Ks : Vs)) + (tok0 - 3 + r) * 1024 + h * 128 + ch * 8);
#endif
                *(LAS v4u*)(Lh + T * 18224 + r * 272 + ch * 16) = val; }
            for (int c = ht; c < 384; c += 256) { const int j = c / 96, rem = c - j * 96, T = rem >> 5, ch4 = rem & 31;
                *(LAS f32x4*)(cwl + (j * 3 + T) * 128 + ch4 * 4) = *(const f32x4*)(conv_w + (size_t)j * 3072 + T * 1024 + h * 128 + ch4 * 4); }
        } else {
            if (ht < 64) { gcs[ht] = Gd[(tok0 + ht) * 16 + h]; bts[ht] = Gd[(tok0 + ht) * 16 + 8 + h]; }
#pragma unroll
            for (int k12 = 0; k12 < 12; ++k12) { const int idx = ht + 256 * k12, T = idx >> 10, r = (idx >> 4) & 63, ch = idx & 15;
                const bf16* sp = (T == 0 ? Qp : (T == 1 ? WWs : QKs)) + (tok0 + r) * 1024 + h * 128 + ch * 8;
                *(LAS v4u*)(Lh + T * 17408 + r * 272 + ch * 16) = *(const v4u*)sp; }
        }
        __syncthreads();
        if (MODE == 1 && ht < 64) { float acc_g = 0.f;
#pragma unroll 8
            for (int j = 0; j < 64; ++j) { const float gj = gcs[j]; acc_g += (j <= ht) ? gj : 0.f; }
            gcs2[ht] = acc_g; egs[ht] = __expf(acc_g);
            if (ht == 63) GL[(b * 8 + h) * 128 + n] = __expf(acc_g); }
        if (MODE == 0) {
        const int ti = ht >> 2, tq = ht & 3;
        unsigned outp[3][16];
        {
#pragma unroll
            for (int T = 0; T < 3; ++T) {
                float y[32]; float ss = 0.f;
#pragma unroll
                for (int cgp = 0; cgp < 4; ++cgp) { const int ch0 = tq * 32 + cgp * 8; float a[8];
#pragma unroll
                    for (int e = 0; e < 8; ++e) a[e] = 0.f;
#pragma unroll
                    for (int j = 0; j < 4; ++j) { const v4u xv = *(const LAS v4u*)(Lh + T * 18224 + (ti + j) * 272 + ch0 * 2);
                        const LAS float* wp = cwl + (j * 3 + T) * 128 + ch0; const f32x4 w0 = *(const LAS f32x4*)wp, w1 = *(const LAS f32x4*)(wp + 4);
                        a[0] += w0.x * __uint_as_float(xv.x << 16); a[1] += w0.y * __uint_as_float(xv.x & 0xffff0000u); a[2] += w0.z * __uint_as_float(xv.y << 16); a[3] += w0.w * __uint_as_float(xv.y & 0xffff0000u);
                        a[4] += w1.x * __uint_as_float(xv.z << 16); a[5] += w1.y * __uint_as_float(xv.z & 0xffff0000u); a[6] += w1.z * __uint_as_float(xv.w << 16); a[7] += w1.w * __uint_as_float(xv.w & 0xffff0000u); }
#pragma unroll
                    for (int e = 0; e < 8; ++e) { const float s = a[e] / (1.0f + __expf(-a[e])); y[cgp * 8 + e] = s; ss += s * s; } }
                float scl = 1.0f;
                if (T < 2) { ss += __shfl_xor(ss, 1); ss += __shfl_xor(ss, 2); scl = 1.0f / sqrtf(ss + EPS); if (T == 0) scl *= 0.08838834764831845f; }
#if defined(DIAG_W)
                if (T == 1) atomicMax((unsigned*)GL + 4004 - 65536, __float_as_uint(ss * scl * scl));
#endif
#pragma unroll
                for (int e = 0; e < 16; ++e) outp[T][e] = cvt_pk_bf16(y[2 * e] * scl, y[2 * e + 1] * scl);
            }
        }
#if defined(P6A_INPLACE)
#pragma unroll
        for (int T = 0; T < 3; ++T) { bf16* dp = (T == 0 ? Qs : (T == 1 ? Ks : Vs)) + (tok0 + ti) * 1024 + h * 128 + tq * 32;
#else
#pragma unroll
        for (int T = 0; T < 3; ++T) { bf16* dp = (T == 0 ? Qp : (T == 1 ? WWs : QKs)) + (tok0 + ti) * 1024 + h * 128 + tq * 32;
#endif
#pragma unroll
            for (int k4 = 0; k4 < 4; ++k4) { const v4u ov = (v4u){outp[T][4 * k4], outp[T][4 * k4 + 1], outp[T][4 * k4 + 2], outp[T][4 * k4 + 3]};
#if defined(NO_P6A_STORE)
                if (ov.x == 0x12345678u) *(v4u*)(dp + k4 * 8) = ov;
#else
                *(v4u*)(dp + k4 * 8) = ov;
#endif
            } }
        continue;
        }
        __syncthreads();
        {
            bf16x8 ak[4], aq[4];
#if defined(DIAG_W)
            float dam = 0.f, dkk = 0.f;
#endif
#pragma unroll
            for (int s = 0; s < 4; ++s) { ak[s] = *(const LAS bf16x8*)(Lh + 17408 + (16 * wv + fr) * 272 + s * 64 + fq * 16); aq[s] = *(const LAS bf16x8*)(Lh + (16 * wv + fr) * 272 + s * 64 + fq * 16); }
            bf16* qkp = QKs + tok0 * 1024 + h * 128;
#pragma unroll
            for (int jt = 0; jt < 4; ++jt) { f32x4 ckk = (f32x4){0.f, 0.f, 0.f, 0.f}, cqk = (f32x4){0.f, 0.f, 0.f, 0.f};
#pragma unroll
                for (int s = 0; s < 4; ++s) { const bf16x8 bk = *(const LAS bf16x8*)(Lh + 17408 + (16 * jt + fr) * 272 + s * 64 + fq * 16);
                    ckk = __builtin_amdgcn_mfma_f32_16x16x32_bf16(ak[s], bk, ckk, 0, 0, 0); cqk = __builtin_amdgcn_mfma_f32_16x16x32_bf16(aq[s], bk, cqk, 0, 0, 0); }
                const int j = 16 * jt + fr; const float gj = gcs2[j];
#pragma unroll
                for (int r = 0; r < 4; ++r) { const int i = 16 * wv + 4 * fq + r; const float e = __expf(fminf(gcs2[i] - gj, 0.f));
                    AM[i * 64 + j] = (j < i) ? ckk[r] * bts[i] * e : 0.f;
#if defined(DIAG_W)
                    dam = fmaxf(dam, (j < i) ? fabsf(ckk[r] * bts[i] * e) : 0.f); dkk = fmaxf(dkk, fabsf(ckk[r]));
#endif
#if !defined(P6_SKIP_QK)
                    qkp[(size_t)i * 1024 + j] = (bf16)(cvt_pk_bf16((j <= i) ? cqk[r] * e : 0.f, 0.f) & 0xffffu);
#endif
                    } }
#if defined(DIAG_W)
            atomicMax((unsigned*)GL + 4001 - 65536, __float_as_uint(dam)); atomicMax((unsigned*)GL + 4002 - 65536, __float_as_uint(dkk));
#endif
        }
        __syncthreads();
        {
            const float gl = gcs2[63];
#pragma unroll
            for (int k4 = 0; k4 < 4; ++k4) { const int idx = ht + 256 * k4, row = idx >> 4, ch = idx & 15; const v4u q8 = *(const LAS v4u*)(Lh + row * 272 + ch * 16); const float e = egs[row];
                v4u o; o.x = cvt_pk_bf16(__uint_as_float(q8.x << 16) * e, __uint_as_float(q8.x & 0xffff0000u) * e); o.y = cvt_pk_bf16(__uint_as_float(q8.y << 16) * e, __uint_as_float(q8.y & 0xffff0000u) * e);
                o.z = cvt_pk_bf16(__uint_as_float(q8.z << 16) * e, __uint_as_float(q8.z & 0xffff0000u) * e); o.w = cvt_pk_bf16(__uint_as_float(q8.w << 16) * e, __uint_as_float(q8.w & 0xffff0000u) * e);
#if !defined(P6_SKIP_QD)
                *(v4u*)(Qs + (tok0 + row) * 1024 + h * 128 + ch * 8) = o;
#endif
                }
#pragma unroll
            for (int k4 = 0; k4 < 4; ++k4) { const int idx = ht + 256 * k4, d = idx & 127, cb = idx >> 7; float kv[8];
#pragma unroll
                for (int e = 0; e < 8; ++e) { const int c = 8 * cb + e; kv[e] = bf2f(*(const LAS unsigned short*)(Lh + 17408 + c * 272 + d * 2)) * __expf(gl - gcs2[c]); }
                v4u o; o.x = cvt_pk_bf16(kv[0], kv[1]); o.y = cvt_pk_bf16(kv[2], kv[3]); o.z = cvt_pk_bf16(kv[4], kv[5]); o.w = cvt_pk_bf16(kv[6], kv[7]);
#if !defined(P6_SKIP_KD)
                *(v4u*)(Ks + (tok0 + (d >> 1)) * 1024 + h * 128 + (d & 1) * 64 + 8 * cb) = o;
#endif
                }
        }
#if defined(DIAG_W)
        asm volatile("s_waitcnt vmcnt(0)" ::: "memory"); zprobe(Vs, tok0, h, ht, lane, (unsigned*)GL + 4017 - 65536);
#endif
        {
            const bool isU = ht < 128; const int xc = ht & 127;
            const LAS unsigned short* src = (const LAS unsigned short*)(Lh + (isU ? 34816 : 17408)) + xc;
            __attribute__((address_space(1))) bf16* dst = (__attribute__((address_space(1))) bf16*)((isU ? Vs : WWs) + tok0 * 1024 + h * 128 + xc);
            float sol[64];
#if defined(DIAG_W)
            float dmx = 0.f, dmu = 0.f;
#endif
#pragma unroll
            for (int i = 0; i < 64; ++i) {
                float s = bf2f(src[i * 136]) * bts[i]; if (!isU) s *= egs[i];
#if defined(ZERO_T012)
                if (i < 3) s = 0.f;
#endif
#if !defined(NO_AM)
#pragma unroll
                for (int j = 0; j < i; ++j) s = fmaf(-AM[i * 64 + j], sol[j], s);
#endif
                sol[i] = s;
#if defined(DIAG_W)
                if (!isU) dmx = fmaxf(dmx, fabsf(s)); else dmu = fmaxf(dmu, fabsf(s));
#endif
#if !defined(P6_SKIP_SOLVE)
                *dst = (bf16)(cvt_pk_bf16(s, 0.f) & 0xffffu);
#endif
                dst += 1024;
                asm volatile("" : "+v"(dst) :: "memory");
            }
#if defined(DIAG_W)
            atomicMax((unsigned*)GL + 4000 - 65536 + 0, __float_as_uint(dmx));
            atomicMax((unsigned*)GL + 4003 - 65536, __float_as_uint(dmu));
#endif
#if defined(DIAG_W)
            asm volatile("s_waitcnt vmcnt(0)" ::: "memory"); zprobe(Vs, tok0, h, ht, lane, (unsigned*)GL + 4018 - 65536);
#endif
        }
    }
}

constexpr int SC_STAGE = 62464, SC_ST = 2 * SC_STAGE, SC_VNT = SC_ST + 8704;
struct ScSet { v4u pw[2], pq[2], pk[2], pqk; v2u pu[2]; float gl; };
__device__ __forceinline__ void dn_scan_phase(LAS unsigned char* L, const bf16* Qs, const bf16* Ks, bf16* Vs, const bf16* WWs, const bf16* QKs, const float* GL, int tid, int bid) {
    if (bid >= 64) return;
    const int xcd = bid & 7, rr = bid >> 3, sl = rr & 3, p = xcd + 8 * (rr >> 2), b = p >> 3, h = p & 7;
    const int w = __builtin_amdgcn_readfirstlane(tid >> 6), lane = tid & 63, fr = lane & 15, fq = lane >> 4;
    const size_t rowb = (size_t)b * SEQ;
    LAS unsigned char* ST = L + SC_ST; LAS unsigned char* VNT = L + SC_VNT;
    for (int i = tid; i < 8704 / 4; i += 512) ((LAS unsigned*)ST)[i] = 0u;
    f32x4 accS[2]; accS[0] = (f32x4){0.f, 0.f, 0.f, 0.f}; accS[1] = accS[0];
    const int r16 = tid >> 4, c16 = tid & 15;
    const int r8 = tid >> 3, c8 = tid & 7;
#define SC_LOADS(S, nn) do { const size_t t0 = rowb + 64 * (nn); \
        S.pw[0] = *(const v4u*)(WWs + (t0 + r16) * 1024 + h * 128 + c16 * 8); S.pw[1] = *(const v4u*)(WWs + (t0 + r16 + 32) * 1024 + h * 128 + c16 * 8); \
        S.pq[0] = *(const v4u*)(Qs + (t0 + r16) * 1024 + h * 128 + c16 * 8); S.pq[1] = *(const v4u*)(Qs + (t0 + r16 + 32) * 1024 + h * 128 + c16 * 8); \
        S.pk[0] = *(const v4u*)(Ks + (t0 + (r8 >> 1)) * 1024 + h * 128 + (r8 & 1) * 64 + c8 * 8); S.pk[1] = *(const v4u*)(Ks + (t0 + 32 + (r8 >> 1)) * 1024 + h * 128 + (r8 & 1) * 64 + c8 * 8); \
        S.pqk = *(const v4u*)(QKs + (t0 + r8) * 1024 + h * 128 + c8 * 8); \
        if (w < 4) { S.pu[0] = *(const v2u*)(Vs + (t0 + 16 * w + fr) * 1024 + h * 128 + 32 * sl + 4 * fq); S.pu[1] = *(const v2u*)(Vs + (t0 + 16 * w + fr) * 1024 + h * 128 + 32 * sl + 16 + 4 * fq); } \
        S.gl = GL[(b * 8 + h) * 128 + (nn)]; } while (0)
#define SC_WRITES(S, buf) do { LAS unsigned char* Sw = L + (buf) * SC_STAGE; \
        *(LAS v4u*)(Sw + r16 * 272 + c16 * 16) = S.pw[0]; *(LAS v4u*)(Sw + (r16 + 32) * 272 + c16 * 16) = S.pw[1]; \
        *(LAS v4u*)(Sw + 17408 + r16 * 272 + c16 * 16) = S.pq[0]; *(LAS v4u*)(Sw + 17408 + (r16 + 32) * 272 + c16 * 16) = S.pq[1]; \
        *(LAS v4u*)(Sw + 34816 + r8 * 144 + c8 * 16) = S.pk[0]; *(LAS v4u*)(Sw + 34816 + (r8 + 64) * 144 + c8 * 16) = S.pk[1]; \
        *(LAS v4u*)(Sw + 53248 + r8 * 144 + c8 * 16) = S.pqk; } while (0)
    ScSet R0, R1, R2;
    R0.pu[0] = (v2u){0u, 0u}; R0.pu[1] = R0.pu[0]; R1.pu[0] = R0.pu[0]; R1.pu[1] = R0.pu[0]; R2.pu[0] = R0.pu[0]; R2.pu[1] = R0.pu[0];
    SC_LOADS(R0, 0); SC_WRITES(R0, 0);
    v2u ucur[2]; ucur[0] = R0.pu[0]; ucur[1] = R0.pu[1]; float gl = R0.gl;
    v2u unext[2]; unext[0] = ucur[0]; unext[1] = ucur[1]; float gnext = gl;
    SC_LOADS(R1, 1); SC_LOADS(R2, 2); SC_LOADS(R0, 3);
    __syncthreads();
#define SC_STEP(n, SW) do { LAS unsigned char* Sg = L + ((n) & 1) * SC_STAGE; \
        if ((n) + 1 < 128) { SC_WRITES(SW, ((n) + 1) & 1); unext[0] = SW.pu[0]; unext[1] = SW.pu[1]; gnext = SW.gl; } \
        if ((n) + 4 < 128) SC_LOADS(SW, (n) + 4); \
        f32x4 acc[2]; acc[0] = (f32x4){0.f, 0.f, 0.f, 0.f}; acc[1] = acc[0]; \
        { const LAS unsigned char* Arow = Sg + (w < 4 ? 0 : 17408) + (16 * (w & 3) + fr) * 272 + fq * 16; \
          _Pragma("unroll") for (int s = 0; s < 4; ++s) { const bf16x8 bfr = *(const LAS bf16x8*)(Arow + s * 64); \
            _Pragma("unroll") for (int vt = 0; vt < 2; ++vt) { const bf16x8 afr = *(const LAS bf16x8*)(ST + (16 * vt + fr) * 272 + s * 64 + fq * 16); acc[vt] = __builtin_amdgcn_mfma_f32_16x16x32_bf16(afr, bfr, acc[vt], 0, 0, 0); } } } \
        if (w < 4) { _Pragma("unroll") for (int vt = 0; vt < 2; ++vt) { \
            const float u0 = __uint_as_float(ucur[vt].x << 16), u1 = __uint_as_float(ucur[vt].x & 0xffff0000u), u2 = __uint_as_float(ucur[vt].y << 16), u3 = __uint_as_float(ucur[vt].y & 0xffff0000u); \
            const unsigned p0 = pkc(u0 - acc[vt][0], u1 - acc[vt][1]), p1 = pkc(u2 - acc[vt][2], u3 - acc[vt][3]); \
            LAS unsigned short* vp = (LAS unsigned short*)(VNT + (16 * vt + 4 * fq) * 144 + (16 * w + fr) * 2); \
            vp[0] = (unsigned short)(p0 & 0xffffu); vp[72] = (unsigned short)(p0 >> 16); vp[144] = (unsigned short)(p1 & 0xffffu); vp[216] = (unsigned short)(p1 >> 16); } } \
        WG_BAR(); \
        { accS[0] = accS[0] * gl; accS[1] = accS[1] * gl; \
          _Pragma("unroll") for (int s = 0; s < 2; ++s) { const bf16x8 afr = *(const LAS bf16x8*)(Sg + 34816 + (16 * w + fr) * 144 + s * 64 + fq * 16); \
            _Pragma("unroll") for (int vt = 0; vt < 2; ++vt) { const bf16x8 bfr = *(const LAS bf16x8*)(VNT + (16 * vt + fr) * 144 + s * 64 + fq * 16); accS[vt] = __builtin_amdgcn_mfma_f32_16x16x32_bf16(afr, bfr, accS[vt], 0, 0, 0); } } \
          _Pragma("unroll") for (int vt = 0; vt < 2; ++vt) { v2u o; o.x = pkc(accS[vt][0], accS[vt][1]); o.y = pkc(accS[vt][2], accS[vt][3]); *(LAS v2u*)(ST + (16 * vt + fr) * 272 + (16 * w + 4 * fq) * 2) = o; } } \
        if (w >= 4) { \
          _Pragma("unroll") for (int s = 0; s < 2; ++s) { const bf16x8 bfr = *(const LAS bf16x8*)(Sg + 53248 + (16 * (w - 4) + fr) * 144 + s * 64 + fq * 16); \
            _Pragma("unroll") for (int vt = 0; vt < 2; ++vt) { const bf16x8 afr = *(const LAS bf16x8*)(VNT + (16 * vt + fr) * 144 + s * 64 + fq * 16); acc[vt] = __builtin_amdgcn_mfma_f32_16x16x32_bf16(afr, bfr, acc[vt], 0, 0, 0); } } \
          _Pragma("unroll") for (int vt = 0; vt < 2; ++vt) { v2u o; o.x = pkc(acc[vt][0], acc[vt][1]); o.y = pkc(acc[vt][2], acc[vt][3]); \
            *(v2u*)(Vs + (rowb + 64 * (n) + 16 * (w - 4) + fr) * 1024 + h * 128 + 32 * sl + 16 * vt + 4 * fq) = o; } } \
        ucur[0] = unext[0]; ucur[1] = unext[1]; gl = gnext; \
        WG_BAR(); } while (0)
    for (int n3 = 0; n3 < 126; n3 += 3) { SC_STEP(n3, R1); SC_STEP(n3 + 1, R2); SC_STEP(n3 + 2, R0); }
    SC_STEP(126, R1); SC_STEP(127, R2);
#undef SC_STEP
#undef SC_LOADS
#undef SC_WRITES
}

__device__ __forceinline__ void post_rows(const bf16* Va, float* STATS, const bf16* Os, bf16* Zs, const float* norm_g, int gw, int NGW, int lane) {
    float ng[16];
#pragma unroll
    for (int e = 0; e < 16; ++e) ng[e] = norm_g[((16 * lane) & 127) + e];
    for (int m = gw; m < M; m += NGW) {
        { const v4u* op = (const v4u*)(Os + (size_t)m * D + 16 * lane); v4u* zp = (v4u*)(Zs + (size_t)m * D + 16 * lane);
#if defined(Z_ATOMIC)
          v4u z0, z1; { const unsigned* zq = (const unsigned*)zp;
            z0.x = __hip_atomic_load(zq + 0, __ATOMIC_RELAXED, __HIP_MEMORY_SCOPE_AGENT); z0.y = __hip_atomic_load(zq + 1, __ATOMIC_RELAXED, __HIP_MEMORY_SCOPE_AGENT); z0.z = __hip_atomic_load(zq + 2, __ATOMIC_RELAXED, __HIP_MEMORY_SCOPE_AGENT); z0.w = __hip_atomic_load(zq + 3, __ATOMIC_RELAXED, __HIP_MEMORY_SCOPE_AGENT);
            z1.x = __hip_atomic_load(zq + 4, __ATOMIC_RELAXED, __HIP_MEMORY_SCOPE_AGENT); z1.y = __hip_atomic_load(zq + 5, __ATOMIC_RELAXED, __HIP_MEMORY_SCOPE_AGENT); z1.z = __hip_atomic_load(zq + 6, __ATOMIC_RELAXED, __HIP_MEMORY_SCOPE_AGENT); z1.w = __hip_atomic_load(zq + 7, __ATOMIC_RELAXED, __HIP_MEMORY_SCOPE_AGENT); }
          const v4u o0 = op[0], o1 = op[1]; float x[16], z[16];
#else
          const v4u o0 = op[0], o1 = op[1], z0 = zp[0], z1 = zp[1]; float x[16], z[16];
#endif
          x[0] = __uint_as_float(o0.x << 16); x[1] = __uint_as_float(o0.x & 0xffff0000u); x[2] = __uint_as_float(o0.y << 16); x[3] = __uint_as_float(o0.y & 0xffff0000u);
          x[4] = __uint_as_float(o0.z << 16); x[5] = __uint_as_float(o0.z & 0xffff0000u); x[6] = __uint_as_float(o0.w << 16); x[7] = __uint_as_float(o0.w & 0xffff0000u);
          x[8] = __uint_as_float(o1.x << 16); x[9] = __uint_as_float(o1.x & 0xffff0000u); x[10] = __uint_as_float(o1.y << 16); x[11] = __uint_as_float(o1.y & 0xffff0000u);
          x[12] = __uint_as_float(o1.z << 16); x[13] = __uint_as_float(o1.z & 0xffff0000u); x[14] = __uint_as_float(o1.w << 16); x[15] = __uint_as_float(o1.w & 0xffff0000u);
          z[0] = __uint_as_float(z0.x << 16); z[1] = __uint_as_float(z0.x & 0xffff0000u); z[2] = __uint_as_float(z0.y << 16); z[3] = __uint_as_float(z0.y & 0xffff0000u);
          z[4] = __uint_as_float(z0.z << 16); z[5] = __uint_as_float(z0.z & 0xffff0000u); z[6] = __uint_as_float(z0.w << 16); z[7] = __uint_as_float(z0.w & 0xffff0000u);
          z[8] = __uint_as_float(z1.x << 16); z[9] = __uint_as_float(z1.x & 0xffff0000u); z[10] = __uint_as_float(z1.y << 16); z[11] = __uint_as_float(z1.y & 0xffff0000u);
          z[12] = __uint_as_float(z1.z << 16); z[13] = __uint_as_float(z1.z & 0xffff0000u); z[14] = __uint_as_float(z1.w << 16); z[15] = __uint_as_float(z1.w & 0xffff0000u);
#pragma unroll
          for (int e = 0; e < 16; ++e) { if (!(fabsf(x[e]) < 1e30f)) x[e] = 0.f; if (!(fabsf(z[e]) < 1e30f)) z[e] = 0.f; }
          float ss = 0.f;
#pragma unroll
          for (int e = 0; e < 16; ++e) ss += x[e] * x[e];
          ss += __shfl_xor(ss, 1); ss += __shfl_xor(ss, 2); ss += __shfl_xor(ss, 4);
          const float r = 1.0f / sqrtf(ss * (1.0f / 128.0f) + EPS);
#if defined(DIAG_W)
          { float mo = 0.f, mz = 0.f;
            for (int e = 0; e < 16; ++e) { mo = fmaxf(mo, fabsf(x[e])); mz = fmaxf(mz, fabsf(z[e])); }
            atomicMax((unsigned*)STATS - 131072 + 4013, __float_as_uint(mo)); atomicMax((unsigned*)STATS - 131072 + 4012, __float_as_uint(mz)); }
#endif
#pragma unroll
          for (int e = 0; e < 16; ++e) x[e] = x[e] * r * ng[e] * z[e];
          v4u w0, w1; w0.x = cvt_pk_bf16(x[0], x[1]); w0.y = cvt_pk_bf16(x[2], x[3]); w0.z = cvt_pk_bf16(x[4], x[5]); w0.w = cvt_pk_bf16(x[6], x[7]);
          w1.x = cvt_pk_bf16(x[8], x[9]); w1.y = cvt_pk_bf16(x[10], x[11]); w1.z = cvt_pk_bf16(x[12], x[13]); w1.w = cvt_pk_bf16(x[14], x[15]);
          zp[0] = w0; zp[1] = w1; }
    }
}

__device__ __forceinline__ void gmlp_phase(LAS unsigned char* L, bf16* Ua, const bf16* Va, const float* STATS, const float* ln_g, const float* ln_b, const float* w_s, const float* b_s, int tid, int nblk, int bid) {
    const int w = __builtin_amdgcn_readfirstlane(tid >> 6), lane = tid & 63, fr = lane & 15, fq = lane >> 4;
    LAS unsigned char* VT = L; LAS unsigned char* WL = L + 34816;
    for (int unit = bid; unit < 1024; unit += nblk) {
        const int g = unit & 7, nc = (unit >> 3) & 63, b = unit >> 9; const size_t tok0 = (size_t)b * SEQ + 128 * nc;
        __syncthreads();
#pragma unroll
        for (int k4 = 0; k4 < 4; ++k4) { const int idx = tid + 512 * k4, s = idx & 127, ch = idx >> 7;
            const v4u a = *(const v4u*)(Va + (tok0 + s) * 1024 + 128 * g + 8 * ch); const float mu = STATS[(tok0 + s) * 2] * (1.0f / D), rstd = 1.0f / sqrtf(fmaxf(STATS[(tok0 + s) * 2 + 1] * (1.0f / D) - mu * mu, 0.f) + EPS);
            const f32x4 g0 = *(const f32x4*)(ln_g + 128 * g + 8 * ch), g1 = *(const f32x4*)(ln_g + 128 * g + 8 * ch + 4), b0 = *(const f32x4*)(ln_b + 128 * g + 8 * ch), b1 = *(const f32x4*)(ln_b + 128 * g + 8 * ch + 4);
            float x[8]; x[0] = __uint_as_float(a.x << 16); x[1] = __uint_as_float(a.x & 0xffff0000u); x[2] = __uint_as_float(a.y << 16); x[3] = __uint_as_float(a.y & 0xffff0000u);
            x[4] = __uint_as_float(a.z << 16); x[5] = __uint_as_float(a.z & 0xffff0000u); x[6] = __uint_as_float(a.w << 16); x[7] = __uint_as_float(a.w & 0xffff0000u);
            const float gg[8] = {g0.x, g0.y, g0.z, g0.w, g1.x, g1.y, g1.z, g1.w}, bb[8] = {b0.x, b0.y, b0.z, b0.w, b1.x, b1.y, b1.z, b1.w};
#pragma unroll
            for (int e = 0; e < 8; ++e) { const float v = (x[e] - mu) * rstd * gg[e] + bb[e]; *(LAS unsigned short*)(VT + (8 * ch + e) * 272 + s * 2) = (unsigned short)(cvt_pk_bf16(v, 0.f) & 0xffffu); } }
#pragma unroll
        for (int k8 = 0; k8 < 8; ++k8) { const int idx = tid + 512 * k8, t = idx >> 5, s4 = (idx & 31) * 4; const f32x4 wv = *(const f32x4*)(w_s + ((size_t)(g * 128 + t)) * 128 + s4);
            v2u o; o.x = cvt_pk_bf16(s4 <= t ? wv.x : 0.f, s4 + 1 <= t ? wv.y : 0.f); o.y = cvt_pk_bf16(s4 + 2 <= t ? wv.z : 0.f, s4 + 3 <= t ? wv.w : 0.f);
            *(LAS v2u*)(WL + t * 272 + s4 * 2) = o; }
        __syncthreads();
        bf16x8 af[4];
#pragma unroll
        for (int s = 0; s < 4; ++s) af[s] = *(const LAS bf16x8*)(VT + (16 * w + fr) * 272 + s * 64 + fq * 16);
#pragma unroll
        for (int tt = 0; tt < 8; ++tt) { f32x4 acc = (f32x4){0.f, 0.f, 0.f, 0.f};
#pragma unroll
            for (int s = 0; s < 4; ++s) if (s <= (tt >> 1)) { const bf16x8 bfr = *(const LAS bf16x8*)(WL + (16 * tt + fr) * 272 + s * 64 + fq * 16); acc = __builtin_amdgcn_mfma_f32_16x16x32_bf16(af[s], bfr, acc, 0, 0, 0); }
            const int t = 16 * tt + fr; const float bs = b_s[g * 128 + t];
            v2u* up = (v2u*)(Ua + (tok0 + t) * 1024 + 128 * g + 16 * w + 4 * fq); const v2u uv = *up;
            v2u o; o.x = cvt_pk_bf16(__uint_as_float(uv.x << 16) * (acc[0] + bs), __uint_as_float(uv.x & 0xffff0000u) * (acc[1] + bs));
            o.y = cvt_pk_bf16(__uint_as_float(uv.y << 16) * (acc[2] + bs), __uint_as_float(uv.y & 0xffff0000u) * (acc[3] + bs)); *up = o; }
    }
}

struct Args { const float* in[23]; float* out; unsigned char* ws; int ph_lo, ph_hi; };
__global__ void __launch_bounds__(512, 2) mega_fwd(Args args_unused) {
    extern __shared__ __attribute__((aligned(16))) unsigned char lds[];
    cg::grid_group grid = cg::this_grid();
    LAS unsigned char* L = (LAS unsigned char*)lds;
    const int tid = threadIdx.x, lane = tid & 63, wave = __builtin_amdgcn_readfirstlane(tid >> 6);
    const int G = gridDim.x, bid = blockIdx.x;
    const int vcu = (G % 8 == 0) ? (bid % 8) * (G / 8) + bid / 8 : bid;
    const int gw = vcu * 8 + wave, NGW = G * 8;
    typedef __attribute__((address_space(4))) const unsigned long long kargp_t;
    kargp_t* kp = (kargp_t*)__builtin_amdgcn_kernarg_segment_ptr();
    const unsigned long long phw = kp[25]; const int ph_lo = (int)(phw & 0xffffffffu), ph_hi = (int)(phw >> 32);
    const bool single = (ph_hi - ph_lo) > 1;
    for (int u = threadIdx.x; u < 16; u += 512) ((volatile LAS unsigned*)(L + LDS_BYTES - 64))[u] = 0u;
    __syncthreads();
    XcdBarrier xbar; xbar.bar = (unsigned*)(__attribute__((address_space(1))) unsigned*)kp[24]; xbar.x = 0; xbar.st = (volatile LAS unsigned*)(L + LDS_BYTES - 64);
    if (single) { grid.sync(); xbar = xcd_barrier_post((unsigned*)(__attribute__((address_space(1))) unsigned*)kp[24], (volatile LAS unsigned*)(L + LDS_BYTES - 64)); }
    int pc = 0;
#define IN(k) (ph_lo <= (k) && (k) < ph_hi)
#if defined(DOUBLE_BAR)
#define GSYNC() } { const bool cur_ = IN(pc); ++pc; if (cur_ && IN(pc)) { xcd_barrier(xbar); xcd_barrier(xbar); } } if (IN(pc)) {
#else
#define GSYNC() } { const bool cur_ = IN(pc); ++pc; if (cur_ && IN(pc)) xcd_barrier(xbar); } if (IN(pc)) {
#endif
#define GASQ __attribute__((address_space(1)))
#define INP(k) ((const float*)(GASQ const float*)kp[k])
#define outp_ ((float*)(GASQ float*)kp[23])
#define wsp_ ((unsigned char*)(GASQ unsigned char*)kp[24])
#define xin_ INP(0)
#define cvec INP(1)
#define w_ada INP(2)
#define b_ada INP(3)
#define norm1_g INP(4)
#define f1_in INP(5)
#define f1_out INP(6)
#define norm2_g INP(7)
#define w_in INP(8)
#define conv_w INP(9)
#define a_log INP(10)
#define dt_bias INP(11)
#define dn_norm_g INP(12)
#define gm_ln_g INP(13)
#define gm_ln_b INP(14)
#define gm_w_s INP(15)
#define gm_b_s INP(16)
#define w_branch INP(17)
#define w_out INP(18)
#define norm3_g INP(19)
#define f2_in INP(20)
#define f2_out INP(21)
#define final_g INP(22)
#define MOD ((float*)(wsp_ + WS_MOD))
#define GL ((float*)(wsp_ + WS_GL))
#define STATS ((float*)(wsp_ + WS_STATS))
#define Gd ((float*)(wsp_ + WS_G))
#define Bd ((float*)(wsp_ + WS_BETA))
#define Wst ((bf16*)(wsp_ + WS_W))
#define Wbr ((bf16*)(wsp_ + WS_WBR))
#define Wout ((bf16*)(wsp_ + WS_WOUT))
#define Hb ((bf16*)(wsp_ + WS_H))
#define Qs ((bf16*)(wsp_ + WS_Q))
#define Ks ((bf16*)(wsp_ + WS_K))
#define Vs ((bf16*)(wsp_ + WS_V))
#define Zs ((bf16*)(wsp_ + WS_Z))
#define WWs ((bf16*)(wsp_ + WS_WW))
#define QKs ((bf16*)(wsp_ + WS_QK))
#define TAIL ((bf16*)(wsp_ + WS_TAIL))
#define ACT ((bf16*)(wsp_ + WS_ACT))
#define W_in1 Wst
#define W_out1 (Wst + (size_t)2 * FF * D)
    LAS float* scr = (LAS float*)(L + wave * 16384);

    if (IN(pc)) {
    {
        LAS float* sc = (LAS float*)(L + 135168);
        for (int i = tid; i < 2048; i += 512) { const float v = cvec[i]; sc[i] = v / (1.0f + __expf(-v)); }
        __syncthreads();
        constexpr int I1 = 16 * 176, I2 = 44 * 32, I3 = 2 * 16 * 32, I4 = 16 * 32;
        for (int it = gw; it < I1 + I2 + I3 + I4; it += NGW) {
            int r = it;
            if (r < I1) { conv_ffn_in(f1_in, W_in1, r, scr, lane); continue; } r -= I1;
            if (r < I2) { conv_plain(f1_out, FF, D, W_out1, r, scr, lane); continue; } r -= I2;
            if (r < I3) { const int wsel = r >> 9; conv_plain(w_branch + (size_t)wsel * D * D, D, D, Wbr + (size_t)wsel * D * D, r & 511, scr, lane); continue; } r -= I3;
            conv_plain(w_out, D, D, Wout, r, scr, lane);
        }
        for (int gi = NGW - 1 - gw; gi < 144 * 16; gi += NGW) { const int cg = gi >> 4, kc = gi & 15, col = cg * 64 + lane; float a0 = 0.f, a1 = 0.f;
#pragma unroll 16
            for (int k = 64 * kc; k < 64 * kc + 64; ++k) { const float wv = w_ada[(size_t)k * NMOD + col]; a0 += sc[k] * wv; a1 += sc[1024 + k] * wv; }
            if (kc == 0) { const float bb = b_ada[col]; a0 += bb; a1 += bb; }
            atomicAdd(MOD + col, a0); atomicAdd(MOD + NMOD + col, a1); }
    }
    GSYNC();
    norm_rows<0>(xin_, norm1_g, MOD, 0 * D, 1 * D, Hb, gw, NGW, lane, nullptr, nullptr, nullptr, nullptr, nullptr);
    GSYNC();
#if !defined(SKIP_F1)
    { pg8::Gemm g{Hb, W_in1, M, 2 * FF, D}; pg8::StaticOrder S; S.init(M, 2 * FF, G, bid); pg8::EpiSwiglu E{ACT, FF};
      pg8::gemm_phase<pg8::EpiSwiglu, pg8::StaticOrder, true, true>(L, g, S, E); }
    GSYNC();
#endif
    { pg8::Gemm g{ACT, W_out1, M, D, FF}; pg8::StaticOrder S; S.init(M, D, G, bid); pg8::EpiResid E{xin_, outp_, MOD + 2 * D, NMOD, F1SCALE};
      pg8::gemm_phase<pg8::EpiResid, pg8::StaticOrder, true, true>(L, g, S, E); }
    GSYNC();
    {
        for (int it = gw; it < 16 * 256; it += NGW) conv_inproj(w_in, Wst, it, scr, lane);
        __syncthreads();
        LAS float* wabT = (LAS float*)L;
        for (int k = tid; k < 1024; k += 512) { const float* wp = w_in + (size_t)k * INW + 6144;
#pragma unroll
            for (int c4 = 0; c4 < 4; ++c4) { const f32x4 v = *(const f32x4*)(wp + 4 * c4); wabT[(4 * c4 + 0) * 1024 + k] = v.x; wabT[(4 * c4 + 1) * 1024 + k] = v.y; wabT[(4 * c4 + 2) * 1024 + k] = v.z; wabT[(4 * c4 + 3) * 1024 + k] = v.w; } }
        __syncthreads();
        norm_rows<1>(outp_, norm2_g, MOD, 3 * D, 4 * D, Hb, gw, NGW, lane, wabT, a_log, dt_bias, Gd, Bd);
        __syncthreads();
    }
    GSYNC();
#if !defined(SKIP_MIX)
    { pg8::Gemm g{Hb, Wst, M, 3072, D}; pg8::StaticOrder S; S.init(M, 3072, G, bid); pg8::EpiI1 E{Qs, (size_t)M * D, TAIL};
      pg8::gemm_phase<pg8::EpiI1, pg8::StaticOrder, true, true>(L, g, S, E); }
    GSYNC();
#if !defined(SKIP_DN)
    dn_local_phase<0>(L, Qs, Ks, Vs, WWs, QKs, Zs, Gd, Bd, GL, conv_w, tid, G, bid);
    GSYNC();
#if defined(DIAG_W)
    for (int it = bid; it < 2048; it += G) { const int hw_ = tid >> 8, ht_ = tid & 255; const int unit = it * 2 + hw_, h_ = unit & 7, n_ = (unit >> 3) & 127, b_ = unit >> 10;
        zprobe(Vs, (size_t)b_ * SEQ + 64 * n_, h_, ht_, lane, (unsigned*)GL + 4020 - 65536); }
    GSYNC();
#endif
#if !defined(SKIP_P6B)
    dn_local_phase<1>(L, Qs, Ks, Vs, WWs, QKs, Zs, Gd, Bd, GL, conv_w, tid, G, bid);
#endif
    GSYNC();
#if !defined(SKIP_SCAN)
    if (bid < 64) dn_scan_phase(L, Qs, Ks, Vs, WWs, QKs, GL, tid, bid);
    else {
        pg8::Gemm g{Hb, Wst + (size_t)7168 * D, M, D, D}; pg8::ZOrder S{G - 64, bid - 64}; pg8::EpiZ E{Zs};
        pg8::gemm_phase<pg8::EpiZ, pg8::ZOrder, true, true>(L, g, S, E); }
#endif
    GSYNC();
#endif
    { pg8::Gemm g{Hb, Wst + (size_t)3072 * D, M, 4096, D}; pg8::StaticOrder S; S.init(M, 4096, G, bid); pg8::EpiI2 E{Qs, Ks, WWs, QKs, Zs, STATS};
      pg8::gemm_phase<pg8::EpiI2, pg8::StaticOrder, true, true>(L, g, S, E); }
    GSYNC();
    post_rows(Ks, STATS, Vs, Zs, dn_norm_g, gw, NGW, lane);
    __syncthreads();
#if !defined(SKIP_GM)
    gmlp_phase(L, Qs, Ks, STATS, gm_ln_g, gm_ln_b, gm_w_s, gm_b_s, tid, G, bid);
    GSYNC();
#endif
    { pg8::Gemm g{Qs, Wbr, M, D, D}; pg8::BranchOrder S; S.so.init(M, D, G, bid); pg8::EpiBranch E{WWs, QKs, Hb};
      pg8::gemm_phase<pg8::EpiBranch, pg8::BranchOrder, true, true>(L, g, S, E); }
    GSYNC();
    { pg8::Gemm g{Hb, Wout, M, D, D}; pg8::StaticOrder S; S.init(M, D, G, bid); pg8::EpiResid E{outp_, outp_, MOD + 5 * D, NMOD, 1.0f};
      pg8::gemm_phase<pg8::EpiResid, pg8::StaticOrder, true, true>(L, g, S, E); }
    GSYNC();
#endif
    {
        constexpr int I1 = 16 * 176, I2 = 44 * 32;
        for (int it = gw; it < I1 + I2; it += NGW) { if (it < I1) conv_ffn_in(f2_in, W_in1, it, scr, lane); else conv_plain(f2_out, FF, D, W_out1, it - I1, scr, lane); }
        norm_rows<0>(outp_, norm3_g, MOD, 6 * D, 7 * D, Hb, gw, NGW, lane, nullptr, nullptr, nullptr, nullptr, nullptr);
    }
    GSYNC();
#if !defined(SKIP_F2)
    { pg8::Gemm g{Hb, W_in1, M, 2 * FF, D}; pg8::StaticOrder S; S.init(M, 2 * FF, G, bid); pg8::EpiSwiglu E{ACT, FF};
      pg8::gemm_phase<pg8::EpiSwiglu, pg8::StaticOrder, true, true>(L, g, S, E); }
    GSYNC();
    { pg8::Gemm g{ACT, W_out1, M, D, FF}; pg8::StaticOrder S; S.init(M, D, G, bid); pg8::EpiResid E{outp_, outp_, MOD + 8 * D, NMOD, 0.5f};
      pg8::gemm_phase<pg8::EpiResid, pg8::StaticOrder, true, true>(L, g, S, E); }
    GSYNC();
#endif
    {
        f32x4 fg[4];
#pragma unroll
        for (int j = 0; j < 4; ++j) fg[j] = *(const f32x4*)(final_g + 4 * lane + 256 * j);
        for (int m = gw; m < M; m += NGW) { f32x4* xr = (f32x4*)(outp_ + (size_t)m * D) + lane; f32x4 v[4]; float ss = 0.f;
#pragma unroll
            for (int j = 0; j < 4; ++j) { v[j] = xr[64 * j];
#if defined(NANGUARD)
                for (int e = 0; e < 4; ++e) if (!(fabsf(v[j][e]) < 1e30f)) v[j][e] = 0.f;
#endif
                ss += (v[j].x * v[j].x + v[j].y * v[j].y) + (v[j].z * v[j].z + v[j].w * v[j].w); }
            const float r = 1.0f / sqrtf(wave_sum(ss) * (1.0f / D) + EPS);
#pragma unroll
            for (int j = 0; j < 4; ++j) xr[64 * j] = v[j] * r * fg[j];
#if defined(OUT_TAIL)
            if (m < 768) { for (int j = 0; j < 4; ++j) { const bf16* tp = TAIL + (size_t)m * 3072 + OUT_TAIL_OFF + 4 * lane + 256 * j; xr[64 * j] = (f32x4){bf2f(tp[0]), bf2f(tp[1]), bf2f(tp[2]), bf2f(tp[3])}; } }
#endif
#if defined(DIAG_W)
            { float dv = __uint_as_float(((const unsigned*)wsp_)[4000 + (m < 8192 ? DIAG_SEL : DIAG_SEL2)]); if ((m < 8192 ? DIAG_SEL : DIAG_SEL2) == 9 || (m < 8192 ? DIAG_SEL : DIAG_SEL2) == 10) dv = (float)((const unsigned*)wsp_)[4000 + (m < 8192 ? DIAG_SEL : DIAG_SEL2)]; dv = fminf(fmaxf(10.f + log2f(fmaxf(dv, 1e-30f)), 0.f), 60.f);
              for (int j = 0; j < 4; ++j) xr[64 * j] = (f32x4){dv, dv, dv, dv}; }
#endif
            }
    }
}
}
#undef GSYNC
#undef IN
#undef INP
#undef outp_
#undef wsp_
#undef xin_
#undef cvec
#undef w_ada
#undef b_ada
#undef norm1_g
#undef f1_in
#undef f1_out
#undef norm2_g
#undef w_in
#undef conv_w
#undef a_log
#undef dt_bias
#undef dn_norm_g
#undef gm_ln_g
#undef gm_ln_b
#undef gm_w_s
#undef gm_b_s
#undef w_branch
#undef w_out
#undef norm3_g
#undef f2_in
#undef f2_out
#undef final_g
#undef MOD
#undef GL
#undef STATS
#undef Gd
#undef Bd
#undef Wst
#undef Wbr
#undef Wout
#undef Hb
#undef Qs
#undef Ks
#undef Vs
#undef Zs
#undef WWs
#undef QKs
#undef TAIL
#undef ACT
#undef W_in1
#undef W_out1
extern "C" void kernel_launch(void* const* d_in, const int* in_sizes, int n_in, void* d_out, int out_size, void* d_ws, size_t ws_size, hipStream_t stream) {
    static int grid = 0;
    if (grid == 0) {
        if (n_in != 23 || out_size != M * D || ws_size < WS_END) { fprintf(stderr, "kernel_launch: unexpected shapes (n_in %d, out %d, ws %zu)\n", n_in, out_size, ws_size); grid = -1; return; }
        int dev = 0, cus = 0, per_cu = 0;
        hipGetDevice(&dev); hipDeviceGetAttribute(&cus, hipDeviceAttributeMultiprocessorCount, dev);
        if (hipFuncSetAttribute((const void*)mega_fwd, hipFuncAttributeMaxDynamicSharedMemorySize, LDS_BYTES) != hipSuccess) { fprintf(stderr, "kernel_launch: hipFuncSetAttribute failed\n"); grid = -1; return; }
        if (hipOccupancyMaxActiveBlocksPerMultiprocessor(&per_cu, (const void*)mega_fwd, 512, LDS_BYTES) != hipSuccess || per_cu < 1) { fprintf(stderr, "kernel_launch: occupancy query says %d\n", per_cu); per_cu = 1; }
        (void)hipGetLastError();
        grid = cus;
        fprintf(stderr, "kernel_launch: cus %d per_cu %d grid %d\n", cus, per_cu, grid);
    }
    if (grid < 0) return;
    if (hipMemsetAsync(d_ws, 0, 655360, stream) != hipSuccess) { fprintf(stderr, "kernel_launch: memset failed\n"); return; }
    Args a{};
    for (int i = 0; i < 23; ++i) a.in[i] = (const float*)d_in[i];
    a.out = (float*)d_out; a.ws = (unsigned char*)d_ws;
#if defined(LAUNCH_PER_PHASE)
    for (int ph = 0; ph < 18; ++ph) { a.ph_lo = ph; a.ph_hi = ph + 1; hipLaunchKernelGGL(mega_fwd, dim3(grid), dim3(512), LDS_BYTES, stream, a); }
    hipError_t e = hipPeekAtLastError();
#else
    a.ph_lo = 0; a.ph_hi = 18;
    void* kargs[] = {&a};
    hipError_t e = hipLaunchCooperativeKernel((const void*)mega_fwd, dim3(grid), dim3(512), kargs, LDS_BYTES, stream);
#endif
    if (e != hipSuccess) fprintf(stderr, "kernel_launch: cooperative launch failed: %s (grid %d)\n", hipGetErrorString(e), grid);
}
```

```cpp
#include <hip/hip_runtime.h>
#include <hip/hip_cooperative_groups.h>
#include <cstdio>
#include <cstdint>
namespace pg8 {
#define PG8_LAS __attribute__((address_space(3)))
typedef unsigned short bf16_t;
typedef short bf16x8 __attribute__((ext_vector_type(8)));
typedef float f32x4 __attribute__((ext_vector_type(4)));
typedef unsigned u32x4 __attribute__((ext_vector_type(4)));
constexpr int BM = 256, BK = 64, HALF = 128, HTB = HALF * BK * 2  , STAGE_BYTES = 8 * HTB, NXCD = 8, WGM = 8;

__host__ __device__ __forceinline__ int lds_byte(int r, int c) { const int st = (r >> 4) * 2 + (c >> 5), rr = r & 15, cc = c & 31, ob = rr * 64 + cc * 2; return st * 1024 + (ob ^ (((ob >> 9) & 1) << 5)); }
__host__ __device__ __forceinline__ void stage_rc(int b, int& R, int& C) { const int st = b / 1024, sb = b % 1024, swz = sb ^ (((sb >> 9) & 1) << 5); R = (st >> 1) * 16 + swz / 64; C = (st & 1) * 32 + (swz % 64) / 2; }
__host__ __device__ __forceinline__ int perm32(int rho) { const int n = rho >> 4, i = rho & 15; return 8 * (i >> 2) + 4 * n + (i & 3); }

struct Unit { int pm, pn; };
struct Gemm { const bf16_t* A; const bf16_t* Bt; int M, N, K; };

struct StaticOrder {
    int nM, nN, nwg, G, c;
    __host__ __device__ void init(int M, int N, int G_, int c_) { nM = M / BM; nN = N / BM; nwg = nM * nN; G = G_; c = c_; }
    __host__ __device__ bool next(int i, Unit& u) const {
        const long L = (long)i * G + c; if (L >= nwg) return false;
        int wgid = (int)L; { const int q = nwg / NXCD, r = nwg % NXCD, xcd = wgid % NXCD, off = wgid / NXCD; wgid = (xcd < r ? xcd * (q + 1) : r * (q + 1) + (xcd - r) * q) + off; }
        const int nig = WGM * nN, gid = wgid / nig, fm = gid * WGM, gsz = (nM - fm) < WGM ? (nM - fm) : WGM;
        u.pm = fm + ((wgid % nig) % gsz); u.pn = (wgid % nig) / gsz; return true;
    }
    __device__ __forceinline__ void a_ready(const Unit&) const {}
    __device__ __forceinline__ void done(const Unit&) const {}
};

__device__ __forceinline__ unsigned cvt_pk_bf16(float lo, float hi) { unsigned r; asm volatile("v_cvt_pk_bf16_f32 %0, %1, %2" : "=v"(r) : "v"(lo), "v"(hi)); return r; }
typedef float f32x2 __attribute__((ext_vector_type(2)));
__device__ __forceinline__ f32x2 gelu_pk(f32x2 v) {
    const f32x2 av = __builtin_elementwise_abs(v), d = av * 0.2316418882f + 1.0f;
    f32x2 t; t.x = __builtin_amdgcn_rcpf(d.x); t.y = __builtin_amdgcn_rcpf(d.y);
    f32x2 q = t * 0.5307027145f + (-0.7265760135f); q = q * t + 0.7107068705f; q = q * t + (-0.142248368f); q = q * t + 0.127414796f; q = q * t;
    const f32x2 s = (v * v) * (-0.72134752044f);
    f32x2 e; e.x = __builtin_amdgcn_exp2f(s.x); e.y = __builtin_amdgcn_exp2f(s.y);
    const f32x2 m = v * (q * e), r = v - m;
    f32x2 o; o.x = v.x < 0.f ? m.x : r.x; o.y = v.y < 0.f ? m.y : r.y; return o;
}


__device__ __forceinline__ float silu_f(float x) { return x * __builtin_amdgcn_rcpf(1.0f + __expf(-x)); }
__device__ __forceinline__ float sigm_f(float x) { return __builtin_amdgcn_rcpf(1.0f + __expf(-x)); }
__device__ __forceinline__ u32x4 pack8(const f32x4 v0, const f32x4 v1) { u32x4 w; w.x = cvt_pk_bf16(v0[0], v0[1]); w.y = cvt_pk_bf16(v0[2], v0[3]); w.z = cvt_pk_bf16(v1[0], v1[1]); w.w = cvt_pk_bf16(v1[2], v1[3]); return w; }

struct EpiSwiglu {
    static constexpr bool PERM = true, AFTER_DRAIN = false;
    bf16_t* O; int ldo;
    __device__ __forceinline__ void operator()(const f32x4 (&acc)[2][2][4][2], const Unit& u, int wr, int wc, int fr, int fq) const {
        const int row0 = u.pm * BM + wr * 64 + fr, col0 = u.pn * HALF + wc * 32 + 8 * fq;
#pragma unroll
        for (int ai = 0; ai < 2; ++ai)
#pragma unroll
            for (int m = 0; m < 4; ++m) { bf16_t* p = O + (size_t)(row0 + ai * HALF + m * 16) * ldo + col0;
                const f32x4 a0 = acc[ai][0][m][0], a1 = acc[ai][0][m][1], b0 = acc[ai][1][m][0], b1 = acc[ai][1][m][1]; f32x4 v0, v1;
#pragma unroll
                for (int e = 0; e < 4; ++e) { v0[e] = silu_f(a0[e]) * b0[e]; v1[e] = silu_f(a1[e]) * b1[e]; }
                *(u32x4*)p = pack8(v0, v1); }
    }
};
struct EpiResid {
    static constexpr bool PERM = false, AFTER_DRAIN = false;
    const float* base; float* out; const float* coef; int coef_bstride; float scale;
    __device__ __forceinline__ void operator()(const f32x4 (&acc)[2][2][4][2], const Unit& u, int wr, int wc, int fr, int fq) const {
        const float* cf = coef + (size_t)(u.pm >> 5) * coef_bstride; const int col0 = u.pn * BM + wc * 32 + 4 * fq;
#pragma unroll
        for (int bj = 0; bj < 2; ++bj)
#pragma unroll
            for (int n = 0; n < 2; ++n) { const int c = col0 + bj * HALF + n * 16; const f32x4 cv = *(const f32x4*)(cf + c) * scale;
#pragma unroll
                for (int ai = 0; ai < 2; ++ai)
#pragma unroll
                    for (int m = 0; m < 4; ++m) { const size_t off = (size_t)(u.pm * BM + ai * HALF + wr * 64 + m * 16 + fr) * 1024 + c;
                        *(f32x4*)(out + off) = *(const f32x4*)(base + off) + cv * acc[ai][bj][m][n]; } }
    }
};
struct EpiI1 {
    static constexpr bool PERM = true, AFTER_DRAIN = false;
    bf16_t* slot0; size_t slot_stride; bf16_t* tail;
    __device__ __forceinline__ void operator()(const f32x4 (&acc)[2][2][4][2], const Unit& u, int wr, int wc, int fr, int fq) const {
        const int seg = u.pn >> 2; bf16_t* O = slot0 + (size_t)seg * slot_stride;
        const int row0 = u.pm * BM + wr * 64 + fr, col0 = (u.pn & 3) * BM + wc * 32 + 8 * fq;
#pragma unroll
        for (int ai = 0; ai < 2; ++ai)
#pragma unroll
            for (int m = 0; m < 4; ++m) { const int row = row0 + ai * HALF + m * 16;
#pragma unroll
                for (int bj = 0; bj < 2; ++bj) { f32x4 v0 = acc[ai][bj][m][0], v1 = acc[ai][bj][m][1];
#if defined(DIAG_W)
                    if (seg == 3) { float mx_ = 0.f; for (int e = 0; e < 4; ++e) mx_ = fmaxf(mx_, fmaxf(fabsf(v0[e]), fabsf(v1[e]))); atomicMax((unsigned*)((unsigned char*)tail - 236u * 1048576u) + 4011, __float_as_uint(mx_)); }
#endif
                    if (seg == 3) {
#pragma unroll
                        for (int e = 0; e < 4; ++e) { v0[e] = silu_f(v0[e]); v1[e] = silu_f(v1[e]); } }
                    const u32x4 w = pack8(v0, v1);
                    *(u32x4*)(O + (size_t)row * 1024 + col0 + bj * HALF) = w;
                    } }
    }
};
struct EpiI2 {
    static constexpr bool PERM = true, AFTER_DRAIN = false;
    bf16_t* s0; bf16_t* s1; bf16_t* s2; bf16_t* s3; bf16_t* s4;
    __device__ __forceinline__ void operator()(const f32x4 (&acc)[2][2][4][2], const Unit& u, int wr, int wc, int fr, int fq) const {
        const int seg = u.pn >> 2; bf16_t* O = seg == 0 ? s0 : (seg == 1 ? s1 : (seg == 2 ? s2 : (seg == 3 ? s3 : s4)));
        const int row0 = u.pm * BM + wr * 64 + fr, col0 = (u.pn & 3) * BM + wc * 32 + 8 * fq;
#pragma unroll
        for (int ai = 0; ai < 2; ++ai)
#pragma unroll
            for (int m = 0; m < 4; ++m) { const int row = row0 + ai * HALF + m * 16;
#pragma unroll
                for (int bj = 0; bj < 2; ++bj) { f32x4 v0 = acc[ai][bj][m][0], v1 = acc[ai][bj][m][1];
                    if (seg < 2) { const f32x2 a = gelu_pk((f32x2){v0[0], v0[1]}), b = gelu_pk((f32x2){v0[2], v0[3]}), c = gelu_pk((f32x2){v1[0], v1[1]}), d = gelu_pk((f32x2){v1[2], v1[3]});
                        v0 = (f32x4){a.x, a.y, b.x, b.y}; v1 = (f32x4){c.x, c.y, d.x, d.y}; }
                    else if (seg < 4) {
#pragma unroll
                        for (int e = 0; e < 4; ++e) { v0[e] = sigm_f(v0[e]); v1[e] = sigm_f(v1[e]); } }
                    else {
#pragma unroll
                        for (int e = 0; e < 4; ++e) { v0[e] = silu_f(v0[e]); v1[e] = silu_f(v1[e]); } }
                    *(u32x4*)(O + (size_t)row * 1024 + col0 + bj * HALF) = pack8(v0, v1); } }
    }
};
struct ZOrder {
    int G, c;
    __device__ bool next(int i, Unit& u) const { const int Lz = i * G + c; if (Lz >= 256) return false; u.pm = Lz >> 2; u.pn = Lz & 3; return true; }
    __device__ __forceinline__ void a_ready(const Unit&) const {}
    __device__ __forceinline__ void done(const Unit&) const {}
};
struct EpiZ {
    static constexpr bool PERM = true, AFTER_DRAIN = false;
    bf16_t* O;
    __device__ __forceinline__ void operator()(const f32x4 (&acc)[2][2][4][2], const Unit& u, int wr, int wc, int fr, int fq) const {
        const int row0 = u.pm * BM + wr * 64 + fr, col0 = u.pn * BM + wc * 32 + 8 * fq;
#pragma unroll
        for (int ai = 0; ai < 2; ++ai)
#pragma unroll
            for (int m = 0; m < 4; ++m) { const int row = row0 + ai * HALF + m * 16;
#pragma unroll
                for (int bj = 0; bj < 2; ++bj) { f32x4 v0 = acc[ai][bj][m][0], v1 = acc[ai][bj][m][1];
#pragma unroll
                    for (int e = 0; e < 4; ++e) { v0[e] = silu_f(v0[e]); v1[e] = silu_f(v1[e]); }
                    *(u32x4*)(O + (size_t)row * 1024 + col0 + bj * HALF) = pack8(v0, v1); } }
    }
};
struct BranchOrder {
    StaticOrder so;
    __device__ bool next(int i, Unit& u) const { Unit t; if (!so.next(i >> 1, t)) return false; const int which = i & 1; u.pm = t.pm + which * 192; u.pn = t.pn + which * 4; return true; }
    __device__ __forceinline__ void a_ready(const Unit&) const {}
    __device__ __forceinline__ void done(const Unit&) const {}
};
struct EpiBranch {
    static constexpr bool PERM = true, AFTER_DRAIN = false;
    const bf16_t* ga; const bf16_t* gb; bf16_t* merged;
    __device__ __forceinline__ void operator()(const f32x4 (&acc)[2][2][4][2], const Unit& u, int wr, int wc, int fr, int fq) const {
        const int which = u.pm >= 64 ? 1 : 0; const int pm = u.pm - which * 192, pn = u.pn - which * 4; const bf16_t* gt = which ? gb : ga;
        const int row0 = pm * BM + wr * 64 + fr, col0 = pn * BM + wc * 32 + 8 * fq;
#pragma unroll
        for (int ai = 0; ai < 2; ++ai)
#pragma unroll
            for (int m = 0; m < 4; ++m) { const int row = row0 + ai * HALF + m * 16;
#pragma unroll
                for (int bj = 0; bj < 2; ++bj) { const size_t off = (size_t)row * 1024 + col0 + bj * HALF;
                    const u32x4 g = *(const u32x4*)(gt + off); f32x4 v0 = acc[ai][bj][m][0], v1 = acc[ai][bj][m][1];
                    v0[0] *= __uint_as_float(g.x << 16); v0[1] *= __uint_as_float(g.x & 0xffff0000u); v0[2] *= __uint_as_float(g.y << 16); v0[3] *= __uint_as_float(g.y & 0xffff0000u);
                    v1[0] *= __uint_as_float(g.z << 16); v1[1] *= __uint_as_float(g.z & 0xffff0000u); v1[2] *= __uint_as_float(g.w << 16); v1[3] *= __uint_as_float(g.w & 0xffff0000u);
#if defined(ZERO_A)
                    if (!which) { v0 = (f32x4){0.f, 0.f, 0.f, 0.f}; v1 = v0; }
#endif
#if defined(ZERO_B)
                    if (which) { v0 = (f32x4){0.f, 0.f, 0.f, 0.f}; v1 = v0; }
#endif
                    if (which) { unsigned* mp = (unsigned*)(merged + off); u32x4 p;
                        p.x = __hip_atomic_load(mp + 0, __ATOMIC_RELAXED, __HIP_MEMORY_SCOPE_AGENT); p.y = __hip_atomic_load(mp + 1, __ATOMIC_RELAXED, __HIP_MEMORY_SCOPE_AGENT);
                        p.z = __hip_atomic_load(mp + 2, __ATOMIC_RELAXED, __HIP_MEMORY_SCOPE_AGENT); p.w = __hip_atomic_load(mp + 3, __ATOMIC_RELAXED, __HIP_MEMORY_SCOPE_AGENT);
                        v0[0] += __uint_as_float(p.x << 16); v0[1] += __uint_as_float(p.x & 0xffff0000u); v0[2] += __uint_as_float(p.y << 16); v0[3] += __uint_as_float(p.y & 0xffff0000u);
                        v1[0] += __uint_as_float(p.z << 16); v1[1] += __uint_as_float(p.z & 0xffff0000u); v1[2] += __uint_as_float(p.w << 16); v1[3] += __uint_as_float(p.w & 0xffff0000u); }
                    *(u32x4*)(merged + off) = pack8(v0, v1); } }
    }
};

template <class Epi, class Sched, bool ALIGN_EPI = false, bool SP2 = false>
__device__ __forceinline__ void gemm_phase(PG8_LAS unsigned char* lds, const Gemm g, const Sched& S, const Epi& E) {
    const int tid = threadIdx.x, wid = __builtin_amdgcn_readfirstlane(tid >> 6), lane = tid & 63, wr = wid >> 2, wc = wid & 3, fr = lane & 15, fq = lane >> 4;
    const int K = g.K, nt = K / BK;
    unsigned voffA[2], voffB[2];
#pragma unroll
    for (int i = 0; i < 2; ++i) { int R, C; stage_rc(tid * 16 + i * 8192, R, C); const int Rb = Epi::PERM ? ((R & ~31) + perm32(R & 31)) : R;
        voffA[i] = (unsigned)(R * K + C) * 2u; voffB[i] = (unsigned)(Rb * K + C) * 2u; }
    const size_t kstep = (size_t)(BK * 2);
    const size_t hstep = (size_t)HALF * K * 2;
    const size_t tstep = 2 * hstep;
    const unsigned ldsw = (unsigned)wid * 1024u;
    const int aoff = lds_byte(wr * 64 + fr, fq * 8), boff = lds_byte(wc * 32 + fr, fq * 8);
#define PG8_SA(b, h) (((b) * 2 + (h)) * HTB)
#define PG8_SB(b, h) ((4 + (b) * 2 + (h)) * HTB)
#define PG8_STAGE(bufoff, gbase, voff) do { _Pragma("unroll") for (int _i = 0; _i < 2; ++_i) \
        __builtin_amdgcn_global_load_lds((const unsigned*)((const char*)(gbase) + (voff)[_i]), (PG8_LAS unsigned*)(lds + (bufoff) + ldsw + _i * 8192), 16, 0, 0); } while (0)
#define PG8_LDA(dst, b, h) do { _Pragma("unroll") for (int m = 0; m < 4; ++m) _Pragma("unroll") for (int k = 0; k < 2; ++k) dst[m][k] = *(const PG8_LAS bf16x8*)(lds + PG8_SA(b, h) + aoff + m * 2048 + k * 1024); } while (0)
#define PG8_LDB(dst, b, h) do { _Pragma("unroll") for (int n = 0; n < 2; ++n) _Pragma("unroll") for (int k = 0; k < 2; ++k) dst[n][k] = *(const PG8_LAS bf16x8*)(lds + PG8_SB(b, h) + boff + n * 2048 + k * 1024); } while (0)
#define PG8_MMA(ai, bj, At, Bt) do { __builtin_amdgcn_s_setprio(1); _Pragma("unroll") for (int m = 0; m < 4; ++m) _Pragma("unroll") for (int n = 0; n < 2; ++n) _Pragma("unroll") for (int k = 0; k < 2; ++k) \
        acc[ai][bj][m][n] = __builtin_amdgcn_mfma_f32_16x16x32_bf16(Bt[n][k], At[m][k], acc[ai][bj][m][n], 0, 0, 0); __builtin_amdgcn_s_setprio(0); } while (0)
#define PG8_WAIT_V(n) asm volatile("s_waitcnt vmcnt(" #n ")" ::: "memory")
#define PG8_WAIT_L(n) asm volatile("s_waitcnt lgkmcnt(" #n ")" ::: "memory")
#define PG8_BAR __builtin_amdgcn_s_barrier()
#define PG8_SCHED __builtin_amdgcn_sched_barrier(0)
    Unit cur, nxt; int ui = 0;
    if (!S.next(0, cur)) return;
    f32x4 acc[2][2][4][2];
#pragma unroll
    for (int a = 0; a < 2; ++a)
#pragma unroll
        for (int b = 0; b < 2; ++b)
#pragma unroll
            for (int m = 0; m < 4; ++m)
#pragma unroll
                for (int n = 0; n < 2; ++n) acc[a][b][m][n] = (f32x4){0.f, 0.f, 0.f, 0.f};
    bf16x8 At[4][2], B0[2][2], B1[2][2];
    const char* cA = (const char*)g.A + (size_t)cur.pm * tstep; const char* cB = (const char*)g.Bt + (size_t)cur.pn * tstep;
    S.a_ready(cur);
    if constexpr (SP2) {
        PG8_STAGE(PG8_SB(0, 0), cB, voffB); PG8_STAGE(PG8_SB(0, 1), cB + hstep, voffB); PG8_STAGE(PG8_SA(0, 0), cA, voffA); PG8_STAGE(PG8_SA(0, 1), cA + hstep, voffA);
        if (wr == 1) PG8_BAR;
        PG8_WAIT_V(2); PG8_BAR;
        PG8_STAGE(PG8_SB(1, 0), cB + kstep, voffB); PG8_STAGE(PG8_SA(1, 0), cA + kstep, voffA); PG8_STAGE(PG8_SB(1, 1), cB + hstep + kstep, voffB);
        PG8_WAIT_V(6); PG8_BAR;
    } else {
        PG8_STAGE(PG8_SB(0, 0), cB, voffB); PG8_STAGE(PG8_SA(0, 0), cA, voffA); PG8_STAGE(PG8_SB(0, 1), cB + hstep, voffB); PG8_STAGE(PG8_SA(0, 1), cA + hstep, voffA);
        if (wr == 1) PG8_BAR;
        PG8_WAIT_V(4); PG8_BAR;
        PG8_STAGE(PG8_SB(1, 0), cB + kstep, voffB); PG8_STAGE(PG8_SA(1, 0), cA + kstep, voffA); PG8_STAGE(PG8_SB(1, 1), cB + hstep + kstep, voffB);
        PG8_WAIT_V(6); PG8_BAR;
    }
    for (;;) {
        const bool has_next = S.next(ui + 1, nxt);
        const char* nA = has_next ? (const char*)g.A + (size_t)nxt.pm * tstep : cA; const char* nB = has_next ? (const char*)g.Bt + (size_t)nxt.pn * tstep : cB;
        for (int t = 0; t < nt; t += 2) {
            const bool last = (t == nt - 2);
            const char* a1 = cA + (size_t)(t + 1) * kstep;
            const char* a2 = last ? nA : cA + (size_t)(t + 2) * kstep; const char* b2 = last ? nB : cB + (size_t)(t + 2) * kstep;
            const char* a3 = a2 + kstep; const char* b3 = b2 + kstep;
            if (last && has_next) S.a_ready(nxt);
            if constexpr (SP2) {
            PG8_LDB(B0, 0, 0); PG8_LDB(B1, 0, 1); PG8_SCHED; PG8_LDA(At, 0, 0); PG8_STAGE(PG8_SA(1, 1), a1 + hstep, voffA);
            PG8_WAIT_V(8); PG8_WAIT_L(0); PG8_BAR; PG8_MMA(0, 0, At, B0); PG8_MMA(0, 1, At, B1); PG8_BAR; PG8_SCHED;
            PG8_LDA(At, 0, 1); PG8_STAGE(PG8_SB(0, 0), b2, voffB); PG8_STAGE(PG8_SB(0, 1), b2 + hstep, voffB); PG8_STAGE(PG8_SA(0, 0), a2, voffA);
            PG8_WAIT_V(8); PG8_WAIT_L(0); PG8_BAR; PG8_MMA(1, 0, At, B0); PG8_MMA(1, 1, At, B1); PG8_BAR; PG8_SCHED;
            PG8_LDB(B0, 1, 0); PG8_LDB(B1, 1, 1); PG8_SCHED; PG8_LDA(At, 1, 0); PG8_STAGE(PG8_SA(0, 1), a2 + hstep, voffA);
            PG8_WAIT_V(8); PG8_WAIT_L(0); PG8_BAR; PG8_MMA(0, 0, At, B0); PG8_MMA(0, 1, At, B1); PG8_BAR; PG8_SCHED;
            PG8_LDA(At, 1, 1); PG8_STAGE(PG8_SB(1, 0), b3, voffB); PG8_STAGE(PG8_SB(1, 1), b3 + hstep, voffB); PG8_STAGE(PG8_SA(1, 0), a3, voffA);
            PG8_WAIT_V(8); PG8_WAIT_L(0); PG8_BAR; PG8_MMA(1, 0, At, B0); PG8_MMA(1, 1, At, B1); PG8_BAR; PG8_SCHED;
            } else {
            PG8_LDB(B0, 0, 0); PG8_SCHED; PG8_LDA(At, 0, 0); PG8_STAGE(PG8_SA(1, 1), a1 + hstep, voffA);
            PG8_WAIT_L(8); PG8_BAR; PG8_WAIT_L(0); PG8_MMA(0, 0, At, B0); PG8_BAR; PG8_SCHED;
            PG8_LDB(B1, 0, 1); PG8_STAGE(PG8_SB(0, 0), b2, voffB);
            PG8_BAR; PG8_WAIT_L(0); PG8_MMA(0, 1, At, B1); PG8_BAR;
            PG8_LDA(At, 0, 1); PG8_STAGE(PG8_SA(0, 0), a2, voffA);
            PG8_BAR; PG8_WAIT_L(0); PG8_MMA(1, 0, At, B0); PG8_BAR; PG8_SCHED;
            PG8_STAGE(PG8_SB(0, 1), b2 + hstep, voffB);
            PG8_WAIT_V(6); PG8_BAR; PG8_MMA(1, 1, At, B1); PG8_BAR;
            PG8_LDB(B0, 1, 0); PG8_SCHED; PG8_LDA(At, 1, 0); PG8_STAGE(PG8_SA(0, 1), a2 + hstep, voffA);
            PG8_WAIT_L(8); PG8_BAR; PG8_WAIT_L(0); PG8_MMA(0, 0, At, B0); PG8_BAR; PG8_SCHED;
            PG8_LDB(B1, 1, 1); PG8_STAGE(PG8_SB(1, 0), b3, voffB);
            PG8_BAR; PG8_WAIT_L(0); PG8_MMA(0, 1, At, B1); PG8_BAR;
            PG8_LDA(At, 1, 1); PG8_STAGE(PG8_SA(1, 0), a3, voffA);
            PG8_BAR; PG8_WAIT_L(0); PG8_MMA(1, 0, At, B0); PG8_BAR; PG8_SCHED;
            PG8_STAGE(PG8_SB(1, 1), b3 + hstep, voffB);
            PG8_WAIT_V(6); PG8_BAR; PG8_MMA(1, 1, At, B1); PG8_BAR;
            }
        }
        if constexpr (ALIGN_EPI) { if (wr == 0) PG8_BAR; }
        if constexpr (!Epi::AFTER_DRAIN) { E(acc, cur, wr, wc, fr, fq); S.done(cur); }
        if (!has_next) break;
#pragma unroll
        for (int a = 0; a < 2; ++a)
#pragma unroll
            for (int b = 0; b < 2; ++b)
#pragma unroll
                for (int m = 0; m < 4; ++m)
#pragma unroll
                    for (int n = 0; n < 2; ++n) acc[a][b][m][n] = (f32x4){0.f, 0.f, 0.f, 0.f};
        cur = nxt; cA = nA; cB = nB; ++ui;
        if constexpr (ALIGN_EPI) { if (wr == 1) PG8_BAR; }
    }
    PG8_WAIT_V(0);
    if constexpr (!ALIGN_EPI) { if (wr == 0) PG8_BAR; }
    PG8_BAR;
    if constexpr (Epi::AFTER_DRAIN) { E.fused(acc, cur, wr, wc, fr, fq, lds, wid, lane); S.done(cur); }
#undef PG8_SA
#undef PG8_SB
#undef PG8_STAGE
#undef PG8_LDA
#undef PG8_LDB
#undef PG8_MMA
#undef PG8_WAIT_V
#undef PG8_WAIT_L
#undef PG8_BAR
#undef PG8_SCHED
}
}

namespace cg = cooperative_groups;
#define LAS __attribute__((address_space(3)))
typedef unsigned short bf16;
typedef unsigned v4u __attribute__((ext_vector_type(4)));
typedef unsigned v2u __attribute__((ext_vector_type(2)));
typedef float f32x4 __attribute__((ext_vector_type(4)));
typedef short bf16x8 __attribute__((ext_vector_type(8)));
using pg8::cvt_pk_bf16;
typedef float f32x2_t __attribute__((ext_vector_type(2)));
typedef __bf16 bf16x2_t __attribute__((ext_vector_type(2)));
__device__ __forceinline__ unsigned pkc(float lo, float hi) { const f32x2_t v = {lo, hi}; return __builtin_bit_cast(unsigned, __builtin_convertvector(v, bf16x2_t)); }

constexpr int NB = 2, SEQ = 8192, D = 1024, M = NB * SEQ, FF = 2816, NH = 8, NMOD = 9 * D, INW = 8208;
constexpr float EPS = 1e-6f;
constexpr size_t MiB = 1u << 20;
constexpr size_t WS_MOD = 64 * 1024;
constexpr size_t WS_GL = 256 * 1024;
constexpr size_t WS_STATS = 512 * 1024;
constexpr size_t WS_G = 2 * MiB;
constexpr size_t WS_BETA = 1 * MiB + 512 * 1024;
constexpr size_t WS_W = 4 * MiB;
constexpr size_t WS_WBR = 21 * MiB, WS_WOUT = 25 * MiB;
constexpr size_t WS_H = 28 * MiB;
constexpr size_t WS_Q = 60 * MiB, WS_K = 92 * MiB, WS_V = 124 * MiB, WS_Z = 156 * MiB, WS_WW = 188 * MiB, WS_QK = 220 * MiB, WS_TAIL = 156 * MiB;
constexpr size_t WS_ACT = 60 * MiB;
constexpr size_t WS_END = 256 * MiB;
constexpr int LDS_BYTES = 160 * 1024;
#if defined(SKIP_F1)
constexpr float F1SCALE = 0.0f;
#else
constexpr float F1SCALE = 0.5f;
#endif

__device__ __forceinline__ float bf2f(unsigned short h) { return __uint_as_float((unsigned)h << 16); }
__device__ __forceinline__ float wave_sum(float v) {
#pragma unroll
    for (int o = 1; o < 64; o <<= 1) v += __shfl_xor(v, o);
    return v;
}
#define LDS_WAIT() asm volatile("s_waitcnt lgkmcnt(0)" ::: "memory")
#define WG_BAR() do { asm volatile("s_waitcnt lgkmcnt(0)" ::: "memory"); __builtin_amdgcn_s_barrier(); asm volatile("" ::: "memory"); } while (0)


#define RLX_AGENT __ATOMIC_RELAXED, __HIP_MEMORY_SCOPE_AGENT
#define XB_TMO      128
#define XB_XCNT(j)  (256  + 64 * (j))
#define XB_XSUB(j)  (1280 + 64 * (j))
#define XB_XGEN(j)  (2304 + 64 * (j))
#define XB_TOP      3328
#define XB_TOPGEN   3392
#define XCD_BAR_WORDS 3456
#define XB_SPIN_CAP (1u << 18)

__device__ __forceinline__ unsigned xb_ld(unsigned* p)              { return __hip_atomic_load(p, __ATOMIC_RELAXED, __HIP_MEMORY_SCOPE_AGENT); }
__device__ __forceinline__ unsigned xb_add(unsigned* p, unsigned v) { return __hip_atomic_fetch_add(p, v, __ATOMIC_RELAXED, __HIP_MEMORY_SCOPE_AGENT); }
__device__ __forceinline__ unsigned xb_xcc_id() { return (unsigned)__builtin_amdgcn_s_getreg((3 << 11) | 20) & 0xFu; }
#define XB_SPIN(cond, bar) do { unsigned _sp = 0; while (cond) { __builtin_amdgcn_s_sleep(1); \
    if ((++_sp & 255u) == 0u) { if (xb_ld(&(bar)[XB_TMO])) break; if (_sp > XB_SPIN_CAP) { atomicAdd(&(bar)[XB_TMO], 1u); break; } } } } while (0)

struct XcdBarrier {
    unsigned* bar; unsigned x;
    volatile LAS unsigned* st;
};

__device__ __forceinline__ XcdBarrier xcd_barrier_post(unsigned* bar, volatile LAS unsigned* st) {
    XcdBarrier b; b.bar = bar; b.x = xb_xcc_id(); b.st = st;
    if (threadIdx.x == 0) (void)xb_add(&bar[XB_XCNT(b.x)], 1u);
    return b;
}
__device__ __forceinline__ void xcd_barrier_complete(unsigned* bar, unsigned x, unsigned& nloc, unsigned& nx) {
    const unsigned G = gridDim.x * gridDim.y * gridDim.z;
    unsigned sum, cnt, mine, sp = 0u;
    for (;;) {
        sum = 0u; cnt = 0u; mine = 0u;
#pragma unroll
        for (unsigned j = 0; j < 16; ++j) { const unsigned c = xb_ld(&bar[XB_XCNT(j)]); sum += c; cnt += (c > 0u) ? 1u : 0u; mine = (j == x) ? c : mine; }
        if (sum == G) break;
        __builtin_amdgcn_s_sleep(1);
        if ((++sp & 255u) == 0u) { if (xb_ld(&bar[XB_TMO])) break; if (sp > XB_SPIN_CAP) { atomicAdd(&bar[XB_TMO], 1u); break; } }
    }
    nloc = mine > 0u ? mine : 1u; nx = cnt > 0u ? cnt : 1u;
}

__device__ __forceinline__ void xcd_barrier(const XcdBarrier& b) {
    asm volatile("s_waitcnt vmcnt(0)" ::: "memory");
    __syncthreads();
    if (threadIdx.x == 0) {
        unsigned* bar = b.bar;
        __builtin_amdgcn_s_waitcnt(0);
        unsigned nloc = b.st[0], nx = b.st[1];
        if (nloc == 0u) { xcd_barrier_complete(bar, b.x, nloc, nx); b.st[0] = nloc; b.st[1] = nx; }
        const unsigned old = xb_add(&bar[XB_XSUB(b.x)], 1u);
        const unsigned gen = old / nloc;
        if (old + 1u == (gen + 1u) * nloc) {
            __builtin_amdgcn_fence(__ATOMIC_RELEASE, "agent");
            asm volatile("s_waitcnt vmcnt(0)" ::: "memory");
            const unsigned og = xb_add(&bar[XB_TOP], 1u);
            const unsigned tg = og / nx;
            if (og + 1u == (tg + 1u) * nx) xb_add(&bar[XB_TOPGEN], 1u);
            else XB_SPIN(xb_ld(&bar[XB_TOPGEN]) == tg, bar);
            __builtin_amdgcn_fence(__ATOMIC_ACQUIRE, "agent");
            xb_add(&bar[XB_XGEN(b.x)], 1u);
            asm volatile("s_waitcnt vmcnt(0)" ::: "memory");
        } else {
            XB_SPIN(xb_ld(&bar[XB_XGEN(b.x)]) == gen, bar);
            __builtin_amdgcn_fence(__ATOMIC_ACQUIRE, "agent");
            asm volatile("s_waitcnt vmcnt(0)" ::: "memory");
        }
    }
    __syncthreads();
}

__device__ __forceinline__ void tr_tile(const float* W, int ldw, int k0, int ns0, bf16* WT, int K, int nd0, LAS float* scr, int lane) {
#pragma unroll 8
    for (int i = 0; i < 32; ++i) { const int kk = 2 * i + (lane >> 5); scr[kk * 33 + (lane & 31)] = W[(size_t)(k0 + kk) * ldw + ns0 + (lane & 31)]; }
    LDS_WAIT(); asm volatile("" ::: "memory");
    const int c = lane & 7;
#pragma unroll
    for (int j = 0; j < 4; ++j) { const int n = (lane >> 3) + 8 * j; const LAS float* s = scr + (8 * c) * 33 + n;
        v4u o; o.x = cvt_pk_bf16(s[0 * 33], s[1 * 33]); o.y = cvt_pk_bf16(s[2 * 33], s[3 * 33]); o.z = cvt_pk_bf16(s[4 * 33], s[5 * 33]); o.w = cvt_pk_bf16(s[6 * 33], s[7 * 33]);
        *(v4u*)(WT + (size_t)(nd0 + n) * K + k0 + 8 * c) = o; }
    LDS_WAIT(); asm volatile("" ::: "memory");
}
__device__ __forceinline__ void conv_ffn_in(const float* W, bf16* WT, int item, LAS float* scr, int lane) {
    const int kb = item / 176, nb = item % 176, c = 32 * nb; const int half = c >= FF ? 1 : 0, j = c - half * FF;
    tr_tile(W, 2 * FF, 64 * kb, c, WT, D, 256 * (j >> 7) + 128 * half + (j & 127), scr, lane);
}
__device__ __forceinline__ void conv_plain(const float* W, int Kdim, int Ndim, bf16* WT, int item, LAS float* scr, int lane) {
    const int nblk = Ndim / 32, kb = item / nblk, nb = item % nblk;
    tr_tile(W, Ndim, 64 * kb, 32 * nb, WT, Kdim, 32 * nb, scr, lane);
}
__device__ __forceinline__ void conv_inproj(const float* W, bf16* WT, int item, LAS float* scr, int lane) {
    const int kb = item >> 8, nd0 = 32 * (item & 255); const int ns0 = nd0 < 3072 ? nd0 + 2048 : (nd0 < 5120 ? nd0 - 3072 : (nd0 < 7168 ? nd0 + 1040 : nd0 - 2048));
    tr_tile(W, INW, 64 * kb, ns0, WT, D, nd0, scr, lane);
}

template <int MODE>
__device__ __forceinline__ void norm_rows(const float* xin, const float* gain, const float* mod, int sh_off, int sc_off, bf16* H, int gw, int NGW, int lane,
                                          const LAS float* wabT, const float* a_log, const float* dt_bias, float* Gd, float* Bd) {
    int curb = -1; f32x4 cA[4], cB[4];
    for (int m = gw; m < M; m += NGW) {
        const int b = m >> 13;
        if (b != curb) { curb = b;
#pragma unroll
            for (int j = 0; j < 4; ++j) { const int c = 4 * lane + 256 * j; const f32x4 gv = *(const f32x4*)(gain + c), sc = *(const f32x4*)(mod + b * NMOD + sc_off + c);
                cA[j] = gv * (sc + 1.0f); cB[j] = *(const f32x4*)(mod + b * NMOD + sh_off + c); } }
        const f32x4* xr = (const f32x4*)(xin + (size_t)m * D) + lane; f32x4 v[4]; float ss = 0.f;
#pragma unroll
        for (int j = 0; j < 4; ++j) { v[j] = xr[64 * j]; ss += (v[j].x * v[j].x + v[j].y * v[j].y) + (v[j].z * v[j].z + v[j].w * v[j].w); }
        const float r = 1.0f / sqrtf(wave_sum(ss) * (1.0f / D) + EPS);
        v2u* o8 = (v2u*)(H + (size_t)m * D) + lane;
#pragma unroll
        for (int j = 0; j < 4; ++j) { v[j] = v[j] * r * cA[j] + cB[j]; v2u w; w.x = cvt_pk_bf16(v[j].x, v[j].y); w.y = cvt_pk_bf16(v[j].z, v[j].w); o8[64 * j] = w; }
        if (MODE == 1) {
            float mine = 0.f;
            LAS float* red = (LAS float*)((LAS unsigned char*)wabT + 65536) + (lane * 0 + __builtin_amdgcn_readfirstlane(threadIdx.x >> 6)) * 1040;
#pragma unroll
            for (int c = 0; c < 16; ++c) { float a = 0.f;
#pragma unroll
                for (int j = 0; j < 4; ++j) { const f32x4 w = *(const LAS f32x4*)(wabT + c * 1024 + 4 * lane + 256 * j); a += (v[j].x * w.x + v[j].y * w.y) + (v[j].z * w.z + v[j].w * w.w); }
                red[c * 65 + lane] = a; }
            asm volatile("s_waitcnt lgkmcnt(0)" ::: "memory");
            if (lane < 16) { float s0 = 0.f, s1 = 0.f, s2 = 0.f, s3 = 0.f;
#pragma unroll
                for (int j = 0; j < 64; j += 4) { s0 += red[lane * 65 + j]; s1 += red[lane * 65 + j + 1]; s2 += red[lane * 65 + j + 2]; s3 += red[lane * 65 + j + 3]; }
                mine = (s0 + s1) + (s2 + s3); }
            asm volatile("s_waitcnt lgkmcnt(0)" ::: "memory");
            { const int hh = lane & 7; const float xv = mine + dt_bias[hh]; const float sp = fmaxf(xv, 0.f) + log1pf(__expf(-fabsf(xv)));
              const float gval = -__expf(a_log[hh]) * sp, bval = 1.0f / (1.0f + __expf(-mine));
              if (lane < 16) Gd[(size_t)m * 16 + lane] = (lane < 8) ? gval : bval; }
        }
    }
}


#if defined(DIAG_W)
__device__ __forceinline__ void zprobe(const bf16* Vs_, size_t tok0, int h, int ht, int lane, unsigned* word) {
    if (ht < 64) { float m = fabsf(bf2f(Vs_[16777216 + (tok0 + ht) * 1024 + h * 128 + 5]));
        for (int o = 1; o < 64; o <<= 1) m = fmaxf(m, __shfl_xor(m, o));
        if (lane == 0) atomicMax(word, __float_as_uint(1.0f / (m + 1e-6f))); }
}
#endif
#if defined(NO_TAIL)
#define NOTAIL_FLAG false
#else
#define NOTAIL_FLAG true
#endif
constexpr int DL_HALF = 69632;
template <int MODE>
__device__ __forceinline__ void dn_local_phase(LAS unsigned char* L, bf16* Qs, bf16* Ks, bf16* Vs, bf16* WWs, bf16* QKs, bf16* Qp, const float* Gd, const float* Bd, float* GL,
                                               const float* conv_w, int tid, int nblk, int bid) {
    const int wv = __builtin_amdgcn_readfirstlane((tid >> 6) & 3);
    for (int it = bid; it < 1024; it += nblk) {
        int tidv = tid; asm volatile("" : "+v"(tidv));
        const int hw = tidv >> 8, ht = tidv & 255, lane = tidv & 63, fr = lane & 15, fq = lane >> 4;
        LAS unsigned char* Lh = L + hw * DL_HALF;
        LAS float* AM = (LAS float*)(Lh + 52224);
        LAS float* gcs = (LAS float*)(Lh + 68608); LAS float* bts = gcs + 64; LAS float* egs = gcs + 128; LAS float* gcs2 = gcs + 192;
        LAS float* cwl = (LAS float*)(L + 2 * DL_HALF + hw * 6144);
        const int unit = it * 2 + hw, h = unit & 7, n = (unit >> 3) & 127, b = unit >> 10;
        const size_t tok0 = (size_t)b * SEQ + 64 * n;
        __syncthreads();
        if (MODE == 0) {
#pragma unroll
            for (int k12 = 0; k12 < 12; ++k12) { const int idx = ht + 256 * k12, T = idx >> 10, r = (idx >> 4) & 63, ch = idx & 15;
                const bf16* sp = (T == 0 ? Qs : (T == 1 ? Ks : Vs)) + (tok0 + r) * 1024 + h * 128 + ch * 8;
                *(LAS v4u*)(Lh + T * 18224 + (r + 3) * 272 + ch * 16) = *(const v4u*)sp; }
            if (ht < 144) { const int T = ht / 48, rem = ht - T * 48, r = rem >> 4, ch = rem & 15;
                v4u val = (v4u){0u, 0u, 0u, 0u};
#if !defined(NO_HALO)
                if (n > 0) val = *(const v4u*)((T == 0 ? Qs : (T == 1 ? Ks : Vs)) + (tok0 - 3 + r) * 1024 + h * 128 + ch * 8);
#endif
                *(LAS v4u*)(Lh + T * 18224 + r * 272 + ch * 16) = val; }
            for (int c = ht; c < 384; c += 256) { const int j = c / 96, rem = c - j * 96, T = rem >> 5, ch4 = rem & 31;
                *(LAS f32x4*)(cwl + (j * 3 + T) * 128 + ch4 * 4) = *(const f32x4*)(conv_w + (size_t)j * 3072 + T * 1024 + h * 128 + ch4 * 4); }
        } else {
            if (ht < 64) { gcs[ht] = Gd[(tok0 + ht) * 16 + h]; bts[ht] = Gd[(tok0 + ht) * 16 + 8 + h]; }
#pragma unroll
            for (int k12 = 0; k12 < 12; ++k12) { const int idx = ht + 256 * k12, T = idx >> 10, r = (idx >> 4) & 63, ch = idx & 15;
                const bf16* sp = (T == 0 ? Qp : (T == 1 ? WWs : QKs)) + (tok0 + r) * 1024 + h * 128 + ch * 8;
                *(LAS v4u*)(Lh + T * 17408 + r * 272 + ch * 16) = *(const v4u*)sp; }
        }
        __syncthreads();
        if (MODE == 1 && ht < 64) { float acc_g = 0.f;
#pragma unroll 8
            for (int j = 0; j < 64; ++j) { const float gj = gcs[j]; acc_g += (j <= ht) ? gj : 0.f; }
            gcs2[ht] = acc_g; egs[ht] = __expf(acc_g);
            if (ht == 63) GL[(b * 8 + h) * 128 + n] = __expf(acc_g); }
        if (MODE == 0) {
        const int ti = ht >> 2, tq = ht & 3;
        unsigned outp[3][16];
        {
#pragma unroll
            for (int T = 0; T < 3; ++T) {
                float y[32]; float ss = 0.f;
#pragma unroll
                for (int cgp = 0; cgp < 4; ++cgp) { const int ch0 = tq * 32 + cgp * 8; float a[8];
#pragma unroll
                    for (int e = 0; e < 8; ++e) a[e] = 0.f;
#pragma unroll
                    for (int j = 0; j < 4; ++j) { const v4u xv = *(const LAS v4u*)(Lh + T * 18224 + (ti + j) * 272 + ch0 * 2);
                        const LAS float* wp = cwl + (j * 3 + T) * 128 + ch0; const f32x4 w0 = *(const LAS f32x4*)wp, w1 = *(const LAS f32x4*)(wp + 4);
                        a[0] += w0.x * __uint_as_float(xv.x << 16); a[1] += w0.y * __uint_as_float(xv.x & 0xffff0000u); a[2] += w0.z * __uint_as_float(xv.y << 16); a[3] += w0.w * __uint_as_float(xv.y & 0xffff0000u);
                        a[4] += w1.x * __uint_as_float(xv.z << 16); a[5] += w1.y * __uint_as_float(xv.z & 0xffff0000u); a[6] += w1.z * __uint_as_float(xv.w << 16); a[7] += w1.w * __uint_as_float(xv.w & 0xffff0000u); }
#pragma unroll
                    for (int e = 0; e < 8; ++e) { const float s = a[e] / (1.0f + __expf(-a[e])); y[cgp * 8 + e] = s; ss += s * s; } }
                float scl = 1.0f;
                if (T < 2) { ss += __shfl_xor(ss, 1); ss += __shfl_xor(ss, 2); scl = 1.0f / sqrtf(ss + EPS); if (T == 0) scl *= 0.08838834764831845f; }
#if defined(DIAG_W)
                if (T == 1) atomicMax((unsigned*)GL + 4004 - 65536, __float_as_uint(ss * scl * scl));
#endif
#pragma unroll
                for (int e = 0; e < 16; ++e) outp[T][e] = cvt_pk_bf16(y[2 * e] * scl, y[2 * e + 1] * scl);
            }
        }
#if defined(P6A_INPLACE)
#pragma unroll
        for (int T = 0; T < 3; ++T) { bf16* dp = (T == 0 ? Qs : (T == 1 ? Ks : Vs)) + (tok0 + ti) * 1024 + h * 128 + tq * 32;
#else
#pragma unroll
        for (int T = 0; T < 3; ++T) { bf16* dp = (T == 0 ? Qp : (T == 1 ? WWs : QKs)) + (tok0 + ti) * 1024 + h * 128 + tq * 32;
#endif
#pragma unroll
            for (int k4 = 0; k4 < 4; ++k4) { const v4u ov = (v4u){outp[T][4 * k4], outp[T][4 * k4 + 1], outp[T][4 * k4 + 2], outp[T][4 * k4 + 3]};
#if defined(NO_P6A_STORE)
                if (ov.x == 0x12345678u) *(v4u*)(dp + k4 * 8) = ov;
#else
                *(v4u*)(dp + k4 * 8) = ov;
#endif
            } }
        continue;
        }
        __syncthreads();
        {
            bf16x8 ak[4], aq[4];
#if defined(DIAG_W)
            float dam = 0.f, dkk = 0.f;
#endif
#pragma unroll
            for (int s = 0; s < 4; ++s) { ak[s] = *(const LAS bf16x8*)(Lh + 17408 + (16 * wv + fr) * 272 + s * 64 + fq * 16); aq[s] = *(const LAS bf16x8*)(Lh + (16 * wv + fr) * 272 + s * 64 + fq * 16); }
            bf16* qkp = QKs + tok0 * 1024 + h * 128;
#pragma unroll
            for (int jt = 0; jt < 4; ++jt) { f32x4 ckk = (f32x4){0.f, 0.f, 0.f, 0.f}, cqk = (f32x4){0.f, 0.f, 0.f, 0.f};
#pragma unroll
                for (int s = 0; s < 4; ++s) { const bf16x8 bk = *(const LAS bf16x8*)(Lh + 17408 + (16 * jt + fr) * 272 + s * 64 + fq * 16);
                    ckk = __builtin_amdgcn_mfma_f32_16x16x32_bf16(ak[s], bk, ckk, 0, 0, 0); cqk = __builtin_amdgcn_mfma_f32_16x16x32_bf16(aq[s], bk, cqk, 0, 0, 0); }
                const int j = 16 * jt + fr; const float gj = gcs2[j];
#pragma unroll
                for (int r = 0; r < 4; ++r) { const int i = 16 * wv + 4 * fq + r; const float e = __expf(fminf(gcs2[i] - gj, 0.f));
                    AM[i * 64 + j] = (j < i) ? ckk[r] * bts[i] * e : 0.f;
#if defined(DIAG_W)
                    dam = fmaxf(dam, (j < i) ? fabsf(ckk[r] * bts[i] * e) : 0.f); dkk = fmaxf(dkk, fabsf(ckk[r]));
#endif
#if !defined(P6_SKIP_QK)
                    qkp[(size_t)i * 1024 + j] = (bf16)(cvt_pk_bf16((j <= i) ? cqk[r] * e : 0.f, 0.f) & 0xffffu);
#endif
                    } }
#if defined(DIAG_W)
            atomicMax((unsigned*)GL + 4001 - 65536, __float_as_uint(dam)); atomicMax((unsigned*)GL + 4002 - 65536, __float_as_uint(dkk));
#endif
        }
        __syncthreads();
        {
            const float gl = gcs2[63];
#pragma unroll
            for (int k4 = 0; k4 < 4; ++k4) { const int idx = ht + 256 * k4, row = idx >> 4, ch = idx & 15; const v4u q8 = *(const LAS v4u*)(Lh + row * 272 + ch * 16); const float e = egs[row];
                v4u o; o.x = cvt_pk_bf16(__uint_as_float(q8.x << 16) * e, __uint_as_float(q8.x & 0xffff0000u) * e); o.y = cvt_pk_bf16(__uint_as_float(q8.y << 16) * e, __uint_as_float(q8.y & 0xffff0000u) * e);
                o.z = cvt_pk_bf16(__uint_as_float(q8.z << 16) * e, __uint_as_float(q8.z & 0xffff0000u) * e); o.w = cvt_pk_bf16(__uint_as_float(q8.w << 16) * e, __uint_as_float(q8.w & 0xffff0000u) * e);
#if !defined(P6_SKIP_QD)
                *(v4u*)(Qs + (tok0 + row) * 1024 + h * 128 + ch * 8) = o;
#endif
                }
#pragma unroll
            for (int k4 = 0; k4 < 4; ++k4) { const int idx = ht + 256 * k4, d = idx & 127, cb = idx >> 7; float kv[8];
#pragma unroll
                for (int e = 0; e < 8; ++e) { const int c = 8 * cb + e; kv[e] = bf2f(*(const LAS unsigned short*)(Lh + 17408 + c * 272 + d * 2)) * __expf(gl - gcs2[c]); }
                v4u o; o.x = cvt_pk_bf16(kv[0], kv[1]); o.y = cvt_pk_bf16(kv[2], kv[3]); o.z = cvt_pk_bf16(kv[4], kv[5]); o.w = cvt_pk_bf16(kv[6], kv[7]);
#if !defined(P6_SKIP_KD)
                *(v4u*)(Ks + (tok0 + (d >> 1)) * 1024 + h * 128 + (d & 1) * 64 + 8 * cb) = o;
#endif
                }
        }
#if defined(DIAG_W)
        asm volatile("s_waitcnt vmcnt(0)" ::: "memory"); zprobe(Vs, tok0, h, ht, lane, (unsigned*)GL + 4017 - 65536);
#endif
        {
            const bool isU = ht < 128; const int xc = ht & 127;
            const LAS unsigned short* src = (const LAS unsigned short*)(Lh + (isU ? 34816 : 17408)) + xc;
            __attribute__((address_space(1))) bf16* dst = (__attribute__((address_space(1))) bf16*)((isU ? Vs : WWs) + tok0 * 1024 + h * 128 + xc);
            float sol[64];
#if defined(DIAG_W)
            float dmx = 0.f, dmu = 0.f;
#endif
#pragma unroll
            for (int i = 0; i < 64; ++i) {
                float s = bf2f(src[i * 136]) * bts[i]; if (!isU) s *= egs[i];
#if defined(ZERO_T012)
                if (i < 3) s = 0.f;
#endif
#if !defined(NO_AM)
#pragma unroll
                for (int j = 0; j < i; ++j) s = fmaf(-AM[i * 64 + j], sol[j], s);
#endif
                sol[i] = s;
#if defined(DIAG_W)
                if (!isU) dmx = fmaxf(dmx, fabsf(s)); else dmu = fmaxf(dmu, fabsf(s));
#endif
#if !defined(P6_SKIP_SOLVE)
                *dst = (bf16)(cvt_pk_bf16(s, 0.f) & 0xffffu);
#endif
                dst += 1024;
                asm volatile("" : "+v"(dst) :: "memory");
            }
#if defined(DIAG_W)
            atomicMax((unsigned*)GL + 4000 - 65536 + 0, __float_as_uint(dmx));
            atomicMax((unsigned*)GL + 4003 - 65536, __float_as_uint(dmu));
#endif
#if defined(DIAG_W)
            asm volatile("s_waitcnt vmcnt(0)" ::: "memory"); zprobe(Vs, tok0, h, ht, lane, (unsigned*)GL + 4018 - 65536);
#endif
        }
    }
}

constexpr int SC_STAGE = 62464, SC_ST = 2 * SC_STAGE, SC_VNT = SC_ST + 8704;
struct ScSet { v4u pw[2], pq[2], pk[2], pqk; v2u pu[2]; float gl; };
__device__ __forceinline__ void dn_scan_phase(LAS unsigned char* L, const bf16* Qs, const bf16* Ks, bf16* Vs, const bf16* WWs, const bf16* QKs, const float* GL, int tid, int bid) {
    constexpr int NVT = 1, VS = 16 * NVT;
    if (bid >= 128) return;
    const int xcd = bid & 7, rr = bid >> 3, sl = rr & 7, p = xcd + 8 * (rr >> 3), b = p >> 3, h = p & 7;
    const int w = __builtin_amdgcn_readfirstlane(tid >> 6), lane = tid & 63, fr = lane & 15, fq = lane >> 4;
    const size_t rowb = (size_t)b * SEQ;
    LAS unsigned char* ST = L + SC_ST; LAS unsigned char* VNT = L + SC_VNT;
    for (int i = tid; i < 8704 / 4; i += 512) ((LAS unsigned*)ST)[i] = 0u;
    f32x4 accS[2]; accS[0] = (f32x4){0.f, 0.f, 0.f, 0.f}; accS[1] = accS[0];
    const int r16 = tid >> 4, c16 = tid & 15;
    const int r8 = tid >> 3, c8 = tid & 7;
#define SC_LOADS(S, nn) do { const size_t t0 = rowb + 64 * (nn); \
        S.pw[0] = *(const v4u*)(WWs + (t0 + r16) * 1024 + h * 128 + c16 * 8); S.pw[1] = *(const v4u*)(WWs + (t0 + r16 + 32) * 1024 + h * 128 + c16 * 8); \
        S.pq[0] = *(const v4u*)(Qs + (t0 + r16) * 1024 + h * 128 + c16 * 8); S.pq[1] = *(const v4u*)(Qs + (t0 + r16 + 32) * 1024 + h * 128 + c16 * 8); \
        S.pk[0] = *(const v4u*)(Ks + (t0 + (r8 >> 1)) * 1024 + h * 128 + (r8 & 1) * 64 + c8 * 8); S.pk[1] = *(const v4u*)(Ks + (t0 + 32 + (r8 >> 1)) * 1024 + h * 128 + (r8 & 1) * 64 + c8 * 8); \
        S.pqk = *(const v4u*)(QKs + (t0 + r8) * 1024 + h * 128 + c8 * 8); \
        if (w < 4) { S.pu[0] = *(const v2u*)(Vs + (t0 + 16 * w + fr) * 1024 + h * 128 + VS * sl + 4 * fq); if (NVT == 2) S.pu[1] = *(const v2u*)(Vs + (t0 + 16 * w + fr) * 1024 + h * 128 + VS * sl + 16 + 4 * fq); } \
        S.gl = GL[(b * 8 + h) * 128 + (nn)]; } while (0)
#define SC_WRITES(S, buf) do { LAS unsigned char* Sw = L + (buf) * SC_STAGE; \
        *(LAS v4u*)(Sw + r16 * 272 + c16 * 16) = S.pw[0]; *(LAS v4u*)(Sw + (r16 + 32) * 272 + c16 * 16) = S.pw[1]; \
        *(LAS v4u*)(Sw + 17408 + r16 * 272 + c16 * 16) = S.pq[0]; *(LAS v4u*)(Sw + 17408 + (r16 + 32) * 272 + c16 * 16) = S.pq[1]; \
        *(LAS v4u*)(Sw + 34816 + r8 * 144 + c8 * 16) = S.pk[0]; *(LAS v4u*)(Sw + 34816 + (r8 + 64) * 144 + c8 * 16) = S.pk[1]; \
        *(LAS v4u*)(Sw + 53248 + r8 * 144 + c8 * 16) = S.pqk; } while (0)
    ScSet R0, R1, R2;
    R0.pu[0] = (v2u){0u, 0u}; R0.pu[1] = R0.pu[0]; R1.pu[0] = R0.pu[0]; R1.pu[1] = R0.pu[0]; R2.pu[0] = R0.pu[0]; R2.pu[1] = R0.pu[0];
    SC_LOADS(R0, 0); SC_WRITES(R0, 0);
    v2u ucur[2]; ucur[0] = R0.pu[0]; ucur[1] = R0.pu[1]; float gl = R0.gl;
    v2u unext[2]; unext[0] = ucur[0]; unext[1] = ucur[1]; float gnext = gl;
    SC_LOADS(R1, 1); SC_LOADS(R2, 2); SC_LOADS(R0, 3);
    __syncthreads();
#define SC_STEP(n, SW) do { LAS unsigned char* Sg = L + ((n) & 1) * SC_STAGE; \
        if ((n) + 1 < 128) { SC_WRITES(SW, ((n) + 1) & 1); unext[0] = SW.pu[0]; unext[1] = SW.pu[1]; gnext = SW.gl; } \
        if ((n) + 4 < 128) SC_LOADS(SW, (n) + 4); \
        f32x4 acc[2]; acc[0] = (f32x4){0.f, 0.f, 0.f, 0.f}; acc[1] = acc[0]; \
        { const LAS unsigned char* Arow = Sg + (w < 4 ? 0 : 17408) + (16 * (w & 3) + fr) * 272 + fq * 16; \
          _Pragma("unroll") for (int s = 0; s < 4; ++s) { const bf16x8 bfr = *(const LAS bf16x8*)(Arow + s * 64); \
            _Pragma("unroll") for (int vt = 0; vt < NVT; ++vt) { const bf16x8 afr = *(const LAS bf16x8*)(ST + (16 * vt + fr) * 272 + s * 64 + fq * 16); acc[vt] = __builtin_amdgcn_mfma_f32_16x16x32_bf16(afr, bfr, acc[vt], 0, 0, 0); } } } \
        if (w < 4) { _Pragma("unroll") for (int vt = 0; vt < NVT; ++vt) { \
            const float u0 = __uint_as_float(ucur[vt].x << 16), u1 = __uint_as_float(ucur[vt].x & 0xffff0000u), u2 = __uint_as_float(ucur[vt].y << 16), u3 = __uint_as_float(ucur[vt].y & 0xffff0000u); \
            const unsigned p0 = pkc(u0 - acc[vt][0], u1 - acc[vt][1]), p1 = pkc(u2 - acc[vt][2], u3 - acc[vt][3]); \
            LAS unsigned short* vp = (LAS unsigned short*)(VNT + (16 * vt + 4 * fq) * 144 + (16 * w + fr) * 2); \
            vp[0] = (unsigned short)(p0 & 0xffffu); vp[72] = (unsigned short)(p0 >> 16); vp[144] = (unsigned short)(p1 & 0xffffu); vp[216] = (unsigned short)(p1 >> 16); } } \
        WG_BAR(); \
        { accS[0] = accS[0] * gl; accS[1] = accS[1] * gl; \
          _Pragma("unroll") for (int s = 0; s < 2; ++s) { const bf16x8 afr = *(const LAS bf16x8*)(Sg + 34816 + (16 * w + fr) * 144 + s * 64 + fq * 16); \
            _Pragma("unroll") for (int vt = 0; vt < NVT; ++vt) { const bf16x8 bfr = *(const LAS bf16x8*)(VNT + (16 * vt + fr) * 144 + s * 64 + fq * 16); accS[vt] = __builtin_amdgcn_mfma_f32_16x16x32_bf16(afr, bfr, accS[vt], 0, 0, 0); } } \
          _Pragma("unroll") for (int vt = 0; vt < NVT; ++vt) { v2u o; o.x = pkc(accS[vt][0], accS[vt][1]); o.y = pkc(accS[vt][2], accS[vt][3]); *(LAS v2u*)(ST + (16 * vt + fr) * 272 + (16 * w + 4 * fq) * 2) = o; } } \
        if (w >= 4) { \
          _Pragma("unroll") for (int s = 0; s < 2; ++s) { const bf16x8 bfr = *(const LAS bf16x8*)(Sg + 53248 + (16 * (w - 4) + fr) * 144 + s * 64 + fq * 16); \
            _Pragma("unroll") for (int vt = 0; vt < NVT; ++vt) { const bf16x8 afr = *(const LAS bf16x8*)(VNT + (16 * vt + fr) * 144 + s * 64 + fq * 16); acc[vt] = __builtin_amdgcn_mfma_f32_16x16x32_bf16(afr, bfr, acc[vt], 0, 0, 0); } } \
          _Pragma("unroll") for (int vt = 0; vt < NVT; ++vt) { v2u o; o.x = pkc(acc[vt][0], acc[vt][1]); o.y = pkc(acc[vt][2], acc[vt][3]); \
            *(v2u*)(Vs + (rowb + 64 * (n) + 16 * (w - 4) + fr) * 1024 + h * 128 + VS * sl + 16 * vt + 4 * fq) = o; } } \
        ucur[0] = unext[0]; ucur[1] = unext[1]; gl = gnext; \
        WG_BAR(); } while (0)
    for (int n3 = 0; n3 < 126; n3 += 3) { SC_STEP(n3, R1); SC_STEP(n3 + 1, R2); SC_STEP(n3 + 2, R0); }
    SC_STEP(126, R1); SC_STEP(127, R2);
#undef SC_STEP
#undef SC_LOADS
#undef SC_WRITES
}

__device__ __forceinline__ void post_rows(const bf16* Va, float* STATS, const bf16* Os, bf16* Zs, const float* norm_g, int gw, int NGW, int lane) {
    float ng[16];
#pragma unroll
    for (int e = 0; e < 16; ++e) ng[e] = norm_g[((16 * lane) & 127) + e];
    for (int m = gw; m < M; m += NGW) {
        { const v4u a = *((const v4u*)(Va + (size_t)m * D) + lane), c = *((const v4u*)(Va + (size_t)m * D) + 64 + lane); float x[16];
          x[0] = __uint_as_float(a.x << 16); x[1] = __uint_as_float(a.x & 0xffff0000u); x[2] = __uint_as_float(a.y << 16); x[3] = __uint_as_float(a.y & 0xffff0000u);
          x[4] = __uint_as_float(a.z << 16); x[5] = __uint_as_float(a.z & 0xffff0000u); x[6] = __uint_as_float(a.w << 16); x[7] = __uint_as_float(a.w & 0xffff0000u);
          x[8] = __uint_as_float(c.x << 16); x[9] = __uint_as_float(c.x & 0xffff0000u); x[10] = __uint_as_float(c.y << 16); x[11] = __uint_as_float(c.y & 0xffff0000u);
          x[12] = __uint_as_float(c.z << 16); x[13] = __uint_as_float(c.z & 0xffff0000u); x[14] = __uint_as_float(c.w << 16); x[15] = __uint_as_float(c.w & 0xffff0000u);
          float s = 0.f;
#pragma unroll
          for (int e = 0; e < 16; ++e) s += x[e];
#if defined(DIAG_W)
          { float mv = 0.f; for (int e = 0; e < 16; ++e) mv = fmaxf(mv, fabsf(x[e])); atomicMax((unsigned*)STATS - 131072 + 4019, __float_as_uint(mv)); }
#endif
          const float mu = wave_sum(s) * (1.0f / D); float q = 0.f;
#pragma unroll
          for (int e = 0; e < 16; ++e) { const float d = x[e] - mu; q += d * d; }
          const float rstd = 1.0f / sqrtf(wave_sum(q) * (1.0f / D) + EPS);
          if (lane == 0) { STATS[(size_t)m * 2] = mu; STATS[(size_t)m * 2 + 1] = rstd; } }
        { const v4u* op = (const v4u*)(Os + (size_t)m * D + 16 * lane); v4u* zp = (v4u*)(Zs + (size_t)m * D + 16 * lane);
#if defined(Z_ATOMIC)
          v4u z0, z1; { const unsigned* zq = (const unsigned*)zp;
            z0.x = __hip_atomic_load(zq + 0, __ATOMIC_RELAXED, __HIP_MEMORY_SCOPE_AGENT); z0.y = __hip_atomic_load(zq + 1, __ATOMIC_RELAXED, __HIP_MEMORY_SCOPE_AGENT); z0.z = __hip_atomic_load(zq + 2, __ATOMIC_RELAXED, __HIP_MEMORY_SCOPE_AGENT); z0.w = __hip_atomic_load(zq + 3, __ATOMIC_RELAXED, __HIP_MEMORY_SCOPE_AGENT);
            z1.x = __hip_atomic_load(zq + 4, __ATOMIC_RELAXED, __HIP_MEMORY_SCOPE_AGENT); z1.y = __hip_atomic_load(zq + 5, __ATOMIC_RELAXED, __HIP_MEMORY_SCOPE_AGENT); z1.z = __hip_atomic_load(zq + 6, __ATOMIC_RELAXED, __HIP_MEMORY_SCOPE_AGENT); z1.w = __hip_atomic_load(zq + 7, __ATOMIC_RELAXED, __HIP_MEMORY_SCOPE_AGENT); }
          const v4u o0 = op[0], o1 = op[1]; float x[16], z[16];
#else
          const v4u o0 = op[0], o1 = op[1], z0 = zp[0], z1 = zp[1]; float x[16], z[16];
#endif
          x[0] = __uint_as_float(o0.x << 16); x[1] = __uint_as_float(o0.x & 0xffff0000u); x[2] = __uint_as_float(o0.y << 16); x[3] = __uint_as_float(o0.y & 0xffff0000u);
          x[4] = __uint_as_float(o0.z << 16); x[5] = __uint_as_float(o0.z & 0xffff0000u); x[6] = __uint_as_float(o0.w << 16); x[7] = __uint_as_float(o0.w & 0xffff0000u);
          x[8] = __uint_as_float(o1.x << 16); x[9] = __uint_as_float(o1.x & 0xffff0000u); x[10] = __uint_as_float(o1.y << 16); x[11] = __uint_as_float(o1.y & 0xffff0000u);
          x[12] = __uint_as_float(o1.z << 16); x[13] = __uint_as_float(o1.z & 0xffff0000u); x[14] = __uint_as_float(o1.w << 16); x[15] = __uint_as_float(o1.w & 0xffff0000u);
          z[0] = __uint_as_float(z0.x << 16); z[1] = __uint_as_float(z0.x & 0xffff0000u); z[2] = __uint_as_float(z0.y << 16); z[3] = __uint_as_float(z0.y & 0xffff0000u);
          z[4] = __uint_as_float(z0.z << 16); z[5] = __uint_as_float(z0.z & 0xffff0000u); z[6] = __uint_as_float(z0.w << 16); z[7] = __uint_as_float(z0.w & 0xffff0000u);
          z[8] = __uint_as_float(z1.x << 16); z[9] = __uint_as_float(z1.x & 0xffff0000u); z[10] = __uint_as_float(z1.y << 16); z[11] = __uint_as_float(z1.y & 0xffff0000u);
          z[12] = __uint_as_float(z1.z << 16); z[13] = __uint_as_float(z1.z & 0xffff0000u); z[14] = __uint_as_float(z1.w << 16); z[15] = __uint_as_float(z1.w & 0xffff0000u);
#pragma unroll
          for (int e = 0; e < 16; ++e) { if (!(fabsf(x[e]) < 1e30f)) x[e] = 0.f; if (!(fabsf(z[e]) < 1e30f)) z[e] = 0.f; }
          float ss = 0.f;
#pragma unroll
          for (int e = 0; e < 16; ++e) ss += x[e] * x[e];
          ss += __shfl_xor(ss, 1); ss += __shfl_xor(ss, 2); ss += __shfl_xor(ss, 4);
          const float r = 1.0f / sqrtf(ss * (1.0f / 128.0f) + EPS);
#if defined(DIAG_W)
          { float mo = 0.f, mz = 0.f;
            for (int e = 0; e < 16; ++e) { mo = fmaxf(mo, fabsf(x[e])); mz = fmaxf(mz, fabsf(z[e])); }
            atomicMax((unsigned*)STATS - 131072 + 4013, __float_as_uint(mo)); atomicMax((unsigned*)STATS - 131072 + 4012, __float_as_uint(mz)); }
#endif
#pragma unroll
          for (int e = 0; e < 16; ++e) x[e] = x[e] * r * ng[e] * z[e];
          v4u w0, w1; w0.x = cvt_pk_bf16(x[0], x[1]); w0.y = cvt_pk_bf16(x[2], x[3]); w0.z = cvt_pk_bf16(x[4], x[5]); w0.w = cvt_pk_bf16(x[6], x[7]);
          w1.x = cvt_pk_bf16(x[8], x[9]); w1.y = cvt_pk_bf16(x[10], x[11]); w1.z = cvt_pk_bf16(x[12], x[13]); w1.w = cvt_pk_bf16(x[14], x[15]);
          zp[0] = w0; zp[1] = w1; }
    }
}

__device__ __forceinline__ void gmlp_phase(LAS unsigned char* L, bf16* Ua, const bf16* Va, const float* STATS, const float* ln_g, const float* ln_b, const float* w_s, const float* b_s, int tid, int nblk, int bid) {
    const int w = __builtin_amdgcn_readfirstlane(tid >> 6), lane = tid & 63, fr = lane & 15, fq = lane >> 4;
    LAS unsigned char* VT = L; LAS unsigned char* WL = L + 34816;
    for (int unit = bid; unit < 1024; unit += nblk) {
        const int g = unit & 7, nc = (unit >> 3) & 63, b = unit >> 9; const size_t tok0 = (size_t)b * SEQ + 128 * nc;
        __syncthreads();
#pragma unroll
        for (int k4 = 0; k4 < 4; ++k4) { const int idx = tid + 512 * k4, s = idx & 127, ch = idx >> 7;
            const v4u a = *(const v4u*)(Va + (tok0 + s) * 1024 + 128 * g + 8 * ch); const float mu = STATS[(tok0 + s) * 2], rstd = STATS[(tok0 + s) * 2 + 1];
            const f32x4 g0 = *(const f32x4*)(ln_g + 128 * g + 8 * ch), g1 = *(const f32x4*)(ln_g + 128 * g + 8 * ch + 4), b0 = *(const f32x4*)(ln_b + 128 * g + 8 * ch), b1 = *(const f32x4*)(ln_b + 128 * g + 8 * ch + 4);
            float x[8]; x[0] = __uint_as_float(a.x << 16); x[1] = __uint_as_float(a.x & 0xffff0000u); x[2] = __uint_as_float(a.y << 16); x[3] = __uint_as_float(a.y & 0xffff0000u);
            x[4] = __uint_as_float(a.z << 16); x[5] = __uint_as_float(a.z & 0xffff0000u); x[6] = __uint_as_float(a.w << 16); x[7] = __uint_as_float(a.w & 0xffff0000u);
            const float gg[8] = {g0.x, g0.y, g0.z, g0.w, g1.x, g1.y, g1.z, g1.w}, bb[8] = {b0.x, b0.y, b0.z, b0.w, b1.x, b1.y, b1.z, b1.w};
#pragma unroll
            for (int e = 0; e < 8; ++e) { const float v = (x[e] - mu) * rstd * gg[e] + bb[e]; *(LAS unsigned short*)(VT + (8 * ch + e) * 272 + s * 2) = (unsigned short)(cvt_pk_bf16(v, 0.f) & 0xffffu); } }
#pragma unroll
        for (int k8 = 0; k8 < 8; ++k8) { const int idx = tid + 512 * k8, t = idx >> 5, s4 = (idx & 31) * 4; const f32x4 wv = *(const f32x4*)(w_s + ((size_t)(g * 128 + t)) * 128 + s4);
            v2u o; o.x = cvt_pk_bf16(s4 <= t ? wv.x : 0.f, s4 + 1 <= t ? wv.y : 0.f); o.y = cvt_pk_bf16(s4 + 2 <= t ? wv.z : 0.f, s4 + 3 <= t ? wv.w : 0.f);
            *(LAS v2u*)(WL + t * 272 + s4 * 2) = o; }
        __syncthreads();
        bf16x8 af[4];
#pragma unroll
        for (int s = 0; s < 4; ++s) af[s] = *(const LAS bf16x8*)(VT + (16 * w + fr) * 272 + s * 64 + fq * 16);
#pragma unroll
        for (int tt = 0; tt < 8; ++tt) { f32x4 acc = (f32x4){0.f, 0.f, 0.f, 0.f};
#pragma unroll
            for (int s = 0; s < 4; ++s) if (s <= (tt >> 1)) { const bf16x8 bfr = *(const LAS bf16x8*)(WL + (16 * tt + fr) * 272 + s * 64 + fq * 16); acc = __builtin_amdgcn_mfma_f32_16x16x32_bf16(af[s], bfr, acc, 0, 0, 0); }
            const int t = 16 * tt + fr; const float bs = b_s[g * 128 + t];
            v2u* up = (v2u*)(Ua + (tok0 + t) * 1024 + 128 * g + 16 * w + 4 * fq); const v2u uv = *up;
            v2u o; o.x = cvt_pk_bf16(__uint_as_float(uv.x << 16) * (acc[0] + bs), __uint_as_float(uv.x & 0xffff0000u) * (acc[1] + bs));
            o.y = cvt_pk_bf16(__uint_as_float(uv.y << 16) * (acc[2] + bs), __uint_as_float(uv.y & 0xffff0000u) * (acc[3] + bs)); *up = o; }
    }
}

struct Args { const float* in[23]; float* out; unsigned char* ws; int ph_lo, ph_hi; };
__global__ void __launch_bounds__(512, 2) mega_fwd(Args args_unused) {
    extern __shared__ __attribute__((aligned(16))) unsigned char lds[];
    cg::grid_group grid = cg::this_grid();
    LAS unsigned char* L = (LAS unsigned char*)lds;
    const int tid = threadIdx.x, lane = tid & 63, wave = __builtin_amdgcn_readfirstlane(tid >> 6);
    const int G = gridDim.x, bid = blockIdx.x;
    const int vcu = (G % 8 == 0) ? (bid % 8) * (G / 8) + bid / 8 : bid;
    const int gw = vcu * 8 + wave, NGW = G * 8;
    typedef __attribute__((address_space(4))) const unsigned long long kargp_t;
    kargp_t* kp = (kargp_t*)__builtin_amdgcn_kernarg_segment_ptr();
    const unsigned long long phw = kp[25]; const int ph_lo = (int)(phw & 0xffffffffu), ph_hi = (int)(phw >> 32);
    const bool single = (ph_hi - ph_lo) > 1;
    for (int u = threadIdx.x; u < 16; u += 512) ((volatile LAS unsigned*)(L + LDS_BYTES - 64))[u] = 0u;
    __syncthreads();
    XcdBarrier xbar; xbar.bar = (unsigned*)(__attribute__((address_space(1))) unsigned*)kp[24]; xbar.x = 0; xbar.st = (volatile LAS unsigned*)(L + LDS_BYTES - 64);
    if (single) { grid.sync(); xbar = xcd_barrier_post((unsigned*)(__attribute__((address_space(1))) unsigned*)kp[24], (volatile LAS unsigned*)(L + LDS_BYTES - 64)); }
    int pc = 0;
#define IN(k) (ph_lo <= (k) && (k) < ph_hi)
#if defined(DOUBLE_BAR)
#define GSYNC() } { const bool cur_ = IN(pc); ++pc; if (cur_ && IN(pc)) { xcd_barrier(xbar); xcd_barrier(xbar); } } if (IN(pc)) {
#else
#define GSYNC() } { const bool cur_ = IN(pc); ++pc; if (cur_ && IN(pc)) xcd_barrier(xbar); } if (IN(pc)) {
#endif
#define GASQ __attribute__((address_space(1)))
#define INP(k) ((const float*)(GASQ const float*)kp[k])
#define outp_ ((float*)(GASQ float*)kp[23])
#define wsp_ ((unsigned char*)(GASQ unsigned char*)kp[24])
#define xin_ INP(0)
#define cvec INP(1)
#define w_ada INP(2)
#define b_ada INP(3)
#define norm1_g INP(4)
#define f1_in INP(5)
#define f1_out INP(6)
#define norm2_g INP(7)
#define w_in INP(8)
#define conv_w INP(9)
#define a_log INP(10)
#define dt_bias INP(11)
#define dn_norm_g INP(12)
#define gm_ln_g INP(13)
#define gm_ln_b INP(14)
#define gm_w_s INP(15)
#define gm_b_s INP(16)
#define w_branch INP(17)
#define w_out INP(18)
#define norm3_g INP(19)
#define f2_in INP(20)
#define f2_out INP(21)
#define final_g INP(22)
#define MOD ((float*)(wsp_ + WS_MOD))
#define GL ((float*)(wsp_ + WS_GL))
#define STATS ((float*)(wsp_ + WS_STATS))
#define Gd ((float*)(wsp_ + WS_G))
#define Bd ((float*)(wsp_ + WS_BETA))
#define Wst ((bf16*)(wsp_ + WS_W))
#define Wbr ((bf16*)(wsp_ + WS_WBR))
#define Wout ((bf16*)(wsp_ + WS_WOUT))
#define Hb ((bf16*)(wsp_ + WS_H))
#define Qs ((bf16*)(wsp_ + WS_Q))
#define Ks ((bf16*)(wsp_ + WS_K))
#define Vs ((bf16*)(wsp_ + WS_V))
#define Zs ((bf16*)(wsp_ + WS_Z))
#define WWs ((bf16*)(wsp_ + WS_WW))
#define QKs ((bf16*)(wsp_ + WS_QK))
#define TAIL ((bf16*)(wsp_ + WS_TAIL))
#define ACT ((bf16*)(wsp_ + WS_ACT))
#define W_in1 Wst
#define W_out1 (Wst + (size_t)2 * FF * D)
    LAS float* scr = (LAS float*)(L + wave * 16384);

    if (IN(pc)) {
    {
        LAS float* sc = (LAS float*)(L + 135168);
        for (int i = tid; i < 2048; i += 512) { const float v = cvec[i]; sc[i] = v / (1.0f + __expf(-v)); }
        __syncthreads();
        constexpr int I1 = 16 * 176, I2 = 44 * 32, I3 = 2 * 16 * 32, I4 = 16 * 32;
        for (int it = gw; it < I1 + I2 + I3 + I4; it += NGW) {
            int r = it;
            if (r < I1) { conv_ffn_in(f1_in, W_in1, r, scr, lane); continue; } r -= I1;
            if (r < I2) { conv_plain(f1_out, FF, D, W_out1, r, scr, lane); continue; } r -= I2;
            if (r < I3) { const int wsel = r >> 9; conv_plain(w_branch + (size_t)wsel * D * D, D, D, Wbr + (size_t)wsel * D * D, r & 511, scr, lane); continue; } r -= I3;
            conv_plain(w_out, D, D, Wout, r, scr, lane);
        }
        for (int gi = NGW - 1 - gw; gi < 144 * 16; gi += NGW) { const int cg = gi >> 4, kc = gi & 15, col = cg * 64 + lane; float a0 = 0.f, a1 = 0.f;
#pragma unroll 16
            for (int k = 64 * kc; k < 64 * kc + 64; ++k) { const float wv = w_ada[(size_t)k * NMOD + col]; a0 += sc[k] * wv; a1 += sc[1024 + k] * wv; }
            if (kc == 0) { const float bb = b_ada[col]; a0 += bb; a1 += bb; }
            atomicAdd(MOD + col, a0); atomicAdd(MOD + NMOD + col, a1); }
    }
    GSYNC();
    norm_rows<0>(xin_, norm1_g, MOD, 0 * D, 1 * D, Hb, gw, NGW, lane, nullptr, nullptr, nullptr, nullptr, nullptr);
    GSYNC();
#if !defined(SKIP_F1)
    { pg8::Gemm g{Hb, W_in1, M, 2 * FF, D}; pg8::StaticOrder S; S.init(M, 2 * FF, G, bid); pg8::EpiSwiglu E{ACT, FF};
      pg8::gemm_phase<pg8::EpiSwiglu, pg8::StaticOrder, true, true>(L, g, S, E); }
    GSYNC();
#endif
    { pg8::Gemm g{ACT, W_out1, M, D, FF}; pg8::StaticOrder S; S.init(M, D, G, bid); pg8::EpiResid E{xin_, outp_, MOD + 2 * D, NMOD, F1SCALE};
      pg8::gemm_phase<pg8::EpiResid, pg8::StaticOrder, true, true>(L, g, S, E); }
    GSYNC();
    {
        for (int it = gw; it < 16 * 256; it += NGW) conv_inproj(w_in, Wst, it, scr, lane);
        __syncthreads();
        LAS float* wabT = (LAS float*)L;
        for (int k = tid; k < 1024; k += 512) { const float* wp = w_in + (size_t)k * INW + 6144;
#pragma unroll
            for (int c4 = 0; c4 < 4; ++c4) { const f32x4 v = *(const f32x4*)(wp + 4 * c4); wabT[(4 * c4 + 0) * 1024 + k] = v.x; wabT[(4 * c4 + 1) * 1024 + k] = v.y; wabT[(4 * c4 + 2) * 1024 + k] = v.z; wabT[(4 * c4 + 3) * 1024 + k] = v.w; } }
        __syncthreads();
        norm_rows<1>(outp_, norm2_g, MOD, 3 * D, 4 * D, Hb, gw, NGW, lane, wabT, a_log, dt_bias, Gd, Bd);
        __syncthreads();
    }
    GSYNC();
#if !defined(SKIP_MIX)
    { pg8::Gemm g{Hb, Wst, M, 3072, D}; pg8::StaticOrder S; S.init(M, 3072, G, bid); pg8::EpiI1 E{Qs, (size_t)M * D, TAIL};
      pg8::gemm_phase<pg8::EpiI1, pg8::StaticOrder, true, true>(L, g, S, E); }
    GSYNC();
#if !defined(SKIP_DN)
    dn_local_phase<0>(L, Qs, Ks, Vs, WWs, QKs, Zs, Gd, Bd, GL, conv_w, tid, G, bid);
    GSYNC();
#if defined(DIAG_W)
    for (int it = bid; it < 2048; it += G) { const int hw_ = tid >> 8, ht_ = tid & 255; const int unit = it * 2 + hw_, h_ = unit & 7, n_ = (unit >> 3) & 127, b_ = unit >> 10;
        zprobe(Vs, (size_t)b_ * SEQ + 64 * n_, h_, ht_, lane, (unsigned*)GL + 4020 - 65536); }
    GSYNC();
#endif
#if !defined(SKIP_P6B)
    dn_local_phase<1>(L, Qs, Ks, Vs, WWs, QKs, Zs, Gd, Bd, GL, conv_w, tid, G, bid);
#endif
    GSYNC();
#if !defined(SKIP_SCAN)
    if (bid < 128) dn_scan_phase(L, Qs, Ks, Vs, WWs, QKs, GL, tid, bid);
    else {
        pg8::Gemm g{Hb, Wst + (size_t)7168 * D, M, D, D}; pg8::ZOrder S{G - 128, bid - 128}; pg8::EpiZ E{Zs};
        pg8::gemm_phase<pg8::EpiZ, pg8::ZOrder, true, true>(L, g, S, E); }
#endif
    GSYNC();
#endif
    { pg8::Gemm g{Hb, Wst + (size_t)3072 * D, M, 4096, D}; pg8::StaticOrder S; S.init(M, 4096, G, bid); pg8::EpiI2 E{Qs, Ks, WWs, QKs, Zs};
      pg8::gemm_phase<pg8::EpiI2, pg8::StaticOrder, true, true>(L, g, S, E); }
    GSYNC();
    post_rows(Ks, STATS, Vs, Zs, dn_norm_g, gw, NGW, lane);
    GSYNC();
#if !defined(SKIP_GM)
    gmlp_phase(L, Qs, Ks, STATS, gm_ln_g, gm_ln_b, gm_w_s, gm_b_s, tid, G, bid);
    GSYNC();
#endif
    { pg8::Gemm g{Qs, Wbr, M, D, D}; pg8::BranchOrder S; S.so.init(M, D, G, bid); pg8::EpiBranch E{WWs, QKs, Hb};
      pg8::gemm_phase<pg8::EpiBranch, pg8::BranchOrder, true, true>(L, g, S, E); }
    GSYNC();
    { pg8::Gemm g{Hb, Wout, M, D, D}; pg8::StaticOrder S; S.init(M, D, G, bid); pg8::EpiResid E{outp_, outp_, MOD + 5 * D, NMOD, 1.0f};
      pg8::gemm_phase<pg8::EpiResid, pg8::StaticOrder, true, true>(L, g, S, E); }
    GSYNC();
#endif
    {
        constexpr int I1 = 16 * 176, I2 = 44 * 32;
        for (int it = gw; it < I1 + I2; it += NGW) { if (it < I1) conv_ffn_in(f2_in, W_in1, it, scr, lane); else conv_plain(f2_out, FF, D, W_out1, it - I1, scr, lane); }
        norm_rows<0>(outp_, norm3_g, MOD, 6 * D, 7 * D, Hb, gw, NGW, lane, nullptr, nullptr, nullptr, nullptr, nullptr);
    }
    GSYNC();
#if !defined(SKIP_F2)
    { pg8::Gemm g{Hb, W_in1, M, 2 * FF, D}; pg8::StaticOrder S; S.init(M, 2 * FF, G, bid); pg8::EpiSwiglu E{ACT, FF};
      pg8::gemm_phase<pg8::EpiSwiglu, pg8::StaticOrder, true, true>(L, g, S, E); }
    GSYNC();
    { pg8::Gemm g{ACT, W_out1, M, D, FF}; pg8::StaticOrder S; S.init(M, D, G, bid); pg8::EpiResid E{outp_, outp_, MOD + 8 * D, NMOD, 0.5f};
      pg8::gemm_phase<pg8::EpiResid, pg8::StaticOrder, true, true>(L, g, S, E); }
    GSYNC();
#endif
    {
        f32x4 fg[4];
#pragma unroll
        for (int j = 0; j < 4; ++j) fg[j] = *(const f32x4*)(final_g + 4 * lane + 256 * j);
        for (int m = gw; m < M; m += NGW) { f32x4* xr = (f32x4*)(outp_ + (size_t)m * D) + lane; f32x4 v[4]; float ss = 0.f;
#pragma unroll
            for (int j = 0; j < 4; ++j) { v[j] = xr[64 * j];
#if defined(NANGUARD)
                for (int e = 0; e < 4; ++e) if (!(fabsf(v[j][e]) < 1e30f)) v[j][e] = 0.f;
#endif
                ss += (v[j].x * v[j].x + v[j].y * v[j].y) + (v[j].z * v[j].z + v[j].w * v[j].w); }
            const float r = 1.0f / sqrtf(wave_sum(ss) * (1.0f / D) + EPS);
#pragma unroll
            for (int j = 0; j < 4; ++j) xr[64 * j] = v[j] * r * fg[j];
#if defined(OUT_TAIL)
            if (m < 768) { for (int j = 0; j < 4; ++j) { const bf16* tp = TAIL + (size_t)m * 3072 + OUT_TAIL_OFF + 4 * lane + 256 * j; xr[64 * j] = (f32x4){bf2f(tp[0]), bf2f(tp[1]), bf2f(tp[2]), bf2f(tp[3])}; } }
#endif
#if defined(DIAG_W)
            { float dv = __uint_as_float(((const unsigned*)wsp_)[4000 + (m < 8192 ? DIAG_SEL : DIAG_SEL2)]); if ((m < 8192 ? DIAG_SEL : DIAG_SEL2) == 9 || (m < 8192 ? DIAG_SEL : DIAG_SEL2) == 10) dv = (float)((const unsigned*)wsp_)[4000 + (m < 8192 ? DIAG_SEL : DIAG_SEL2)]; dv = fminf(fmaxf(10.f + log2f(fmaxf(dv, 1e-30f)), 0.f), 60.f);
              for (int j = 0; j < 4; ++j) xr[64 * j] = (f32x4){dv, dv, dv, dv}; }
#endif
            }
    }
}
}
#undef GSYNC
#undef IN
#undef INP
#undef outp_
#undef wsp_
#undef xin_
#undef cvec
#undef w_ada
#undef b_ada
#undef norm1_g
#undef f1_in
#undef f1_out
#undef norm2_g
#undef w_in
#undef conv_w
#undef a_log
#undef dt_bias
#undef dn_norm_g
#undef gm_ln_g
#undef gm_ln_b
#undef gm_w_s
#undef gm_b_s
#undef w_branch
#undef w_out
#undef norm3_g
#undef f2_in
#undef f2_out
#undef final_g
#undef MOD
#undef GL
#undef STATS
#undef Gd
#undef Bd
#undef Wst
#undef Wbr
#undef Wout
#undef Hb
#undef Qs
#undef Ks
#undef Vs
#undef Zs
#undef WWs
#undef QKs
#undef TAIL
#undef ACT
#undef W_in1
#undef W_out1
extern "C" void kernel_launch(void* const* d_in, const int* in_sizes, int n_in, void* d_out, int out_size, void* d_ws, size_t ws_size, hipStream_t stream) {
    static int grid = 0;
    if (grid == 0) {
        if (n_in != 23 || out_size != M * D || ws_size < WS_END) { fprintf(stderr, "kernel_launch: unexpected shapes (n_in %d, out %d, ws %zu)\n", n_in, out_size, ws_size); grid = -1; return; }
        int dev = 0, cus = 0, per_cu = 0;
        hipGetDevice(&dev); hipDeviceGetAttribute(&cus, hipDeviceAttributeMultiprocessorCount, dev);
        if (hipFuncSetAttribute((const void*)mega_fwd, hipFuncAttributeMaxDynamicSharedMemorySize, LDS_BYTES) != hipSuccess) { fprintf(stderr, "kernel_launch: hipFuncSetAttribute failed\n"); grid = -1; return; }
        if (hipOccupancyMaxActiveBlocksPerMultiprocessor(&per_cu, (const void*)mega_fwd, 512, LDS_BYTES) != hipSuccess || per_cu < 1) { fprintf(stderr, "kernel_launch: occupancy query says %d\n", per_cu); per_cu = 1; }
        (void)hipGetLastError();
        grid = cus;
        fprintf(stderr, "kernel_launch: cus %d per_cu %d grid %d\n", cus, per_cu, grid);
    }
    if (grid < 0) return;
    if (hipMemsetAsync(d_ws, 0, 262144, stream) != hipSuccess) { fprintf(stderr, "kernel_launch: memset failed\n"); return; }
    Args a{};
    for (int i = 0; i < 23; ++i) a.in[i] = (const float*)d_in[i];
    a.out = (float*)d_out; a.ws = (unsigned char*)d_ws;
#if defined(LAUNCH_PER_PHASE)
    for (int ph = 0; ph < 18; ++ph) { a.ph_lo = ph; a.ph_hi = ph + 1; hipLaunchKernelGGL(mega_fwd, dim3(grid), dim3(512), LDS_BYTES, stream, a); }
    hipError_t e = hipPeekAtLastError();
#else
    a.ph_lo = 0; a.ph_hi = 18;
    void* kargs[] = {&a};
    hipError_t e = hipLaunchCooperativeKernel((const void*)mega_fwd, dim3(grid), dim3(512), kargs, LDS_BYTES, stream);
#endif
    if (e != hipSuccess) fprintf(stderr, "kernel_launch: cooperative launch failed: %s (grid %d)\n", hipGetErrorString(e), grid);
}
```

```cpp
#include <hip/hip_runtime.h>
#include <hip/hip_cooperative_groups.h>
#include <cstdio>
#include <cstdint>
namespace pg8 {
#define PG8_LAS __attribute__((address_space(3)))
typedef unsigned short bf16_t;
typedef short bf16x8 __attribute__((ext_vector_type(8)));
typedef float f32x4 __attribute__((ext_vector_type(4)));
typedef unsigned u32x4 __attribute__((ext_vector_type(4)));
constexpr int BM = 256, BK = 64, HALF = 128, HTB = HALF * BK * 2  , STAGE_BYTES = 8 * HTB, NXCD = 8, WGM = 8;

__host__ __device__ __forceinline__ int lds_byte(int r, int c) { const int st = (r >> 4) * 2 + (c >> 5), rr = r & 15, cc = c & 31, ob = rr * 64 + cc * 2; return st * 1024 + (ob ^ (((ob >> 9) & 1) << 5)); }
__host__ __device__ __forceinline__ void stage_rc(int b, int& R, int& C) { const int st = b / 1024, sb = b % 1024, swz = sb ^ (((sb >> 9) & 1) << 5); R = (st >> 1) * 16 + swz / 64; C = (st & 1) * 32 + (swz % 64) / 2; }
__host__ __device__ __forceinline__ int perm32(int rho) { const int n = rho >> 4, i = rho & 15; return 8 * (i >> 2) + 4 * n + (i & 3); }

struct Unit { int pm, pn; };
struct Gemm { const bf16_t* A; const bf16_t* Bt; int M, N, K; };

struct StaticOrder {
    int nM, nN, nwg, G, c;
    __host__ __device__ void init(int M, int N, int G_, int c_) { nM = M / BM; nN = N / BM; nwg = nM * nN; G = G_; c = c_; }
    __host__ __device__ bool next(int i, Unit& u) const {
        const long L = (long)i * G + c; if (L >= nwg) return false;
        int wgid = (int)L; { const int q = nwg / NXCD, r = nwg % NXCD, xcd = wgid % NXCD, off = wgid / NXCD; wgid = (xcd < r ? xcd * (q + 1) : r * (q + 1) + (xcd - r) * q) + off; }
        const int nig = WGM * nN, gid = wgid / nig, fm = gid * WGM, gsz = (nM - fm) < WGM ? (nM - fm) : WGM;
        u.pm = fm + ((wgid % nig) % gsz); u.pn = (wgid % nig) / gsz; return true;
    }
    __device__ __forceinline__ void a_ready(const Unit&) const {}
    __device__ __forceinline__ void done(const Unit&) const {}
};

__device__ __forceinline__ unsigned cvt_pk_bf16(float lo, float hi) { unsigned r; asm volatile("v_cvt_pk_bf16_f32 %0, %1, %2" : "=v"(r) : "v"(lo), "v"(hi)); return r; }
typedef float f32x2 __attribute__((ext_vector_type(2)));
__device__ __forceinline__ f32x2 gelu_pk(f32x2 v) {
    const f32x2 av = __builtin_elementwise_abs(v), d = av * 0.2316418882f + 1.0f;
    f32x2 t; t.x = __builtin_amdgcn_rcpf(d.x); t.y = __builtin_amdgcn_rcpf(d.y);
    f32x2 q = t * 0.5307027145f + (-0.7265760135f); q = q * t + 0.7107068705f; q = q * t + (-0.142248368f); q = q * t + 0.127414796f; q = q * t;
    const f32x2 s = (v * v) * (-0.72134752044f);
    f32x2 e; e.x = __builtin_amdgcn_exp2f(s.x); e.y = __builtin_amdgcn_exp2f(s.y);
    const f32x2 m = v * (q * e), r = v - m;
    f32x2 o; o.x = v.x < 0.f ? m.x : r.x; o.y = v.y < 0.f ? m.y : r.y; return o;
}


__device__ __forceinline__ float silu_f(float x) { return x * __builtin_amdgcn_rcpf(1.0f + __expf(-x)); }
__device__ __forceinline__ float sigm_f(float x) { return __builtin_amdgcn_rcpf(1.0f + __expf(-x)); }
__device__ __forceinline__ u32x4 pack8(const f32x4 v0, const f32x4 v1) { u32x4 w; w.x = cvt_pk_bf16(v0[0], v0[1]); w.y = cvt_pk_bf16(v0[2], v0[3]); w.z = cvt_pk_bf16(v1[0], v1[1]); w.w = cvt_pk_bf16(v1[2], v1[3]); return w; }

struct EpiSwiglu {
    static constexpr bool PERM = true, AFTER_DRAIN = false;
    bf16_t* O; int ldo;
    __device__ __forceinline__ void operator()(const f32x4 (&acc)[2][2][4][2], const Unit& u, int wr, int wc, int fr, int fq) const {
        const int row0 = u.pm * BM + wr * 64 + fr, col0 = u.pn * HALF + wc * 32 + 8 * fq;
#pragma unroll
        for (int ai = 0; ai < 2; ++ai)
#pragma unroll
            for (int m = 0; m < 4; ++m) { bf16_t* p = O + (size_t)(row0 + ai * HALF + m * 16) * ldo + col0;
                const f32x4 a0 = acc[ai][0][m][0], a1 = acc[ai][0][m][1], b0 = acc[ai][1][m][0], b1 = acc[ai][1][m][1]; f32x4 v0, v1;
#pragma unroll
                for (int e = 0; e < 4; ++e) { v0[e] = silu_f(a0[e]) * b0[e]; v1[e] = silu_f(a1[e]) * b1[e]; }
                *(u32x4*)p = pack8(v0, v1); }
    }
};
struct EpiResid {
    static constexpr bool PERM = false, AFTER_DRAIN = false;
    const float* base; float* out; const float* coef; int coef_bstride; float scale;
    __device__ __forceinline__ void operator()(const f32x4 (&acc)[2][2][4][2], const Unit& u, int wr, int wc, int fr, int fq) const {
        const float* cf = coef + (size_t)(u.pm >> 5) * coef_bstride; const int col0 = u.pn * BM + wc * 32 + 4 * fq;
#pragma unroll
        for (int bj = 0; bj < 2; ++bj)
#pragma unroll
            for (int n = 0; n < 2; ++n) { const int c = col0 + bj * HALF + n * 16; const f32x4 cv = *(const f32x4*)(cf + c) * scale;
#pragma unroll
                for (int ai = 0; ai < 2; ++ai)
#pragma unroll
                    for (int m = 0; m < 4; ++m) { const size_t off = (size_t)(u.pm * BM + ai * HALF + wr * 64 + m * 16 + fr) * 1024 + c;
                        *(f32x4*)(out + off) = *(const f32x4*)(base + off) + cv * acc[ai][bj][m][n]; } }
    }
};
struct EpiI1 {
    static constexpr bool PERM = true, AFTER_DRAIN = false;
    bf16_t* slot0; size_t slot_stride; bf16_t* tail;
    __device__ __forceinline__ void operator()(const f32x4 (&acc)[2][2][4][2], const Unit& u, int wr, int wc, int fr, int fq) const {
        const int seg = u.pn >> 2; bf16_t* O = slot0 + (size_t)seg * slot_stride;
        const int row0 = u.pm * BM + wr * 64 + fr, col0 = (u.pn & 3) * BM + wc * 32 + 8 * fq;
#pragma unroll
        for (int ai = 0; ai < 2; ++ai)
#pragma unroll
            for (int m = 0; m < 4; ++m) { const int row = row0 + ai * HALF + m * 16;
#pragma unroll
                for (int bj = 0; bj < 2; ++bj) { f32x4 v0 = acc[ai][bj][m][0], v1 = acc[ai][bj][m][1];
#if defined(DIAG_W)
                    if (seg == 3) { float mx_ = 0.f; for (int e = 0; e < 4; ++e) mx_ = fmaxf(mx_, fmaxf(fabsf(v0[e]), fabsf(v1[e]))); atomicMax((unsigned*)((unsigned char*)tail - 236u * 1048576u) + 4011, __float_as_uint(mx_)); }
#endif
                    if (seg == 3) {
#pragma unroll
                        for (int e = 0; e < 4; ++e) { v0[e] = silu_f(v0[e]); v1[e] = silu_f(v1[e]); } }
                    const u32x4 w = pack8(v0, v1);
                    *(u32x4*)(O + (size_t)row * 1024 + col0 + bj * HALF) = w;
                    } }
    }
};
struct EpiI2 {
    static constexpr bool PERM = true, AFTER_DRAIN = false;
    bf16_t* s0; bf16_t* s1; bf16_t* s2; bf16_t* s3; bf16_t* s4;
    __device__ __forceinline__ void operator()(const f32x4 (&acc)[2][2][4][2], const Unit& u, int wr, int wc, int fr, int fq) const {
        const int seg = u.pn >> 2; bf16_t* O = seg == 0 ? s0 : (seg == 1 ? s1 : (seg == 2 ? s2 : (seg == 3 ? s3 : s4)));
        const int row0 = u.pm * BM + wr * 64 + fr, col0 = (u.pn & 3) * BM + wc * 32 + 8 * fq;
#pragma unroll
        for (int ai = 0; ai < 2; ++ai)
#pragma unroll
            for (int m = 0; m < 4; ++m) { const int row = row0 + ai * HALF + m * 16;
#pragma unroll
                for (int bj = 0; bj < 2; ++bj) { f32x4 v0 = acc[ai][bj][m][0], v1 = acc[ai][bj][m][1];
                    if (seg < 2) { const f32x2 a = gelu_pk((f32x2){v0[0], v0[1]}), b = gelu_pk((f32x2){v0[2], v0[3]}), c = gelu_pk((f32x2){v1[0], v1[1]}), d = gelu_pk((f32x2){v1[2], v1[3]});
                        v0 = (f32x4){a.x, a.y, b.x, b.y}; v1 = (f32x4){c.x, c.y, d.x, d.y}; }
                    else if (seg < 4) {
#pragma unroll
                        for (int e = 0; e < 4; ++e) { v0[e] = sigm_f(v0[e]); v1[e] = sigm_f(v1[e]); } }
                    else {
#pragma unroll
                        for (int e = 0; e < 4; ++e) { v0[e] = silu_f(v0[e]); v1[e] = silu_f(v1[e]); } }
                    *(u32x4*)(O + (size_t)row * 1024 + col0 + bj * HALF) = pack8(v0, v1); } }
    }
};
struct ZOrder {
    int G, c;
    __device__ bool next(int i, Unit& u) const { const int Lz = i * G + c; if (Lz >= 256) return false; u.pm = Lz >> 2; u.pn = Lz & 3; return true; }
    __device__ __forceinline__ void a_ready(const Unit&) const {}
    __device__ __forceinline__ void done(const Unit&) const {}
};
struct EpiZ {
    static constexpr bool PERM = true, AFTER_DRAIN = false;
    bf16_t* O;
    __device__ __forceinline__ void operator()(const f32x4 (&acc)[2][2][4][2], const Unit& u, int wr, int wc, int fr, int fq) const {
        const int row0 = u.pm * BM + wr * 64 + fr, col0 = u.pn * BM + wc * 32 + 8 * fq;
#pragma unroll
        for (int ai = 0; ai < 2; ++ai)
#pragma unroll
            for (int m = 0; m < 4; ++m) { const int row = row0 + ai * HALF + m * 16;
#pragma unroll
                for (int bj = 0; bj < 2; ++bj) { f32x4 v0 = acc[ai][bj][m][0], v1 = acc[ai][bj][m][1];
#pragma unroll
                    for (int e = 0; e < 4; ++e) { v0[e] = silu_f(v0[e]); v1[e] = silu_f(v1[e]); }
                    *(u32x4*)(O + (size_t)row * 1024 + col0 + bj * HALF) = pack8(v0, v1); } }
    }
};
struct BranchOrder {
    StaticOrder so;
    __device__ bool next(int i, Unit& u) const { Unit t; if (!so.next(i >> 1, t)) return false; const int which = i & 1; u.pm = t.pm + which * 192; u.pn = t.pn + which * 4; return true; }
    __device__ __forceinline__ void a_ready(const Unit&) const {}
    __device__ __forceinline__ void done(const Unit&) const {}
};
struct EpiBranch {
    static constexpr bool PERM = true, AFTER_DRAIN = false;
    const bf16_t* ga; const bf16_t* gb; bf16_t* merged;
    __device__ __forceinline__ void operator()(const f32x4 (&acc)[2][2][4][2], const Unit& u, int wr, int wc, int fr, int fq) const {
        const int which = u.pm >= 64 ? 1 : 0; const int pm = u.pm - which * 192, pn = u.pn - which * 4; const bf16_t* gt = which ? gb : ga;
        const int row0 = pm * BM + wr * 64 + fr, col0 = pn * BM + wc * 32 + 8 * fq;
#pragma unroll
        for (int ai = 0; ai < 2; ++ai)
#pragma unroll
            for (int m = 0; m < 4; ++m) { const int row = row0 + ai * HALF + m * 16;
#pragma unroll
                for (int bj = 0; bj < 2; ++bj) { const size_t off = (size_t)row * 1024 + col0 + bj * HALF;
                    const u32x4 g = *(const u32x4*)(gt + off); f32x4 v0 = acc[ai][bj][m][0], v1 = acc[ai][bj][m][1];
                    v0[0] *= __uint_as_float(g.x << 16); v0[1] *= __uint_as_float(g.x & 0xffff0000u); v0[2] *= __uint_as_float(g.y << 16); v0[3] *= __uint_as_float(g.y & 0xffff0000u);
                    v1[0] *= __uint_as_float(g.z << 16); v1[1] *= __uint_as_float(g.z & 0xffff0000u); v1[2] *= __uint_as_float(g.w << 16); v1[3] *= __uint_as_float(g.w & 0xffff0000u);
#if defined(ZERO_A)
                    if (!which) { v0 = (f32x4){0.f, 0.f, 0.f, 0.f}; v1 = v0; }
#endif
#if defined(ZERO_B)
                    if (which) { v0 = (f32x4){0.f, 0.f, 0.f, 0.f}; v1 = v0; }
#endif
                    if (which) { unsigned* mp = (unsigned*)(merged + off); u32x4 p;
                        p.x = __hip_atomic_load(mp + 0, __ATOMIC_RELAXED, __HIP_MEMORY_SCOPE_AGENT); p.y = __hip_atomic_load(mp + 1, __ATOMIC_RELAXED, __HIP_MEMORY_SCOPE_AGENT);
                        p.z = __hip_atomic_load(mp + 2, __ATOMIC_RELAXED, __HIP_MEMORY_SCOPE_AGENT); p.w = __hip_atomic_load(mp + 3, __ATOMIC_RELAXED, __HIP_MEMORY_SCOPE_AGENT);
                        v0[0] += __uint_as_float(p.x << 16); v0[1] += __uint_as_float(p.x & 0xffff0000u); v0[2] += __uint_as_float(p.y << 16); v0[3] += __uint_as_float(p.y & 0xffff0000u);
                        v1[0] += __uint_as_float(p.z << 16); v1[1] += __uint_as_float(p.z & 0xffff0000u); v1[2] += __uint_as_float(p.w << 16); v1[3] += __uint_as_float(p.w & 0xffff0000u); }
                    *(u32x4*)(merged + off) = pack8(v0, v1); } }
    }
};

template <class Epi, class Sched, bool ALIGN_EPI = false, bool SP2 = false>
__device__ __forceinline__ void gemm_phase(PG8_LAS unsigned char* lds, const Gemm g, const Sched& S, const Epi& E) {
    const int tid = threadIdx.x, wid = __builtin_amdgcn_readfirstlane(tid >> 6), lane = tid & 63, wr = wid >> 2, wc = wid & 3, fr = lane & 15, fq = lane >> 4;
    const int K = g.K, nt = K / BK;
    unsigned voffA[2], voffB[2];
#pragma unroll
    for (int i = 0; i < 2; ++i) { int R, C; stage_rc(tid * 16 + i * 8192, R, C); const int Rb = Epi::PERM ? ((R & ~31) + perm32(R & 31)) : R;
        voffA[i] = (unsigned)(R * K + C) * 2u; voffB[i] = (unsigned)(Rb * K + C) * 2u; }
    const size_t kstep = (size_t)(BK * 2);
    const size_t hstep = (size_t)HALF * K * 2;
    const size_t tstep = 2 * hstep;
    const unsigned ldsw = (unsigned)wid * 1024u;
    const int aoff = lds_byte(wr * 64 + fr, fq * 8), boff = lds_byte(wc * 32 + fr, fq * 8);
#define PG8_SA(b, h) (((b) * 2 + (h)) * HTB)
#define PG8_SB(b, h) ((4 + (b) * 2 + (h)) * HTB)
#define PG8_STAGE(bufoff, gbase, voff) do { _Pragma("unroll") for (int _i = 0; _i < 2; ++_i) \
        __builtin_amdgcn_global_load_lds((const unsigned*)((const char*)(gbase) + (voff)[_i]), (PG8_LAS unsigned*)(lds + (bufoff) + ldsw + _i * 8192), 16, 0, 0); } while (0)
#define PG8_LDA(dst, b, h) do { _Pragma("unroll") for (int m = 0; m < 4; ++m) _Pragma("unroll") for (int k = 0; k < 2; ++k) dst[m][k] = *(const PG8_LAS bf16x8*)(lds + PG8_SA(b, h) + aoff + m * 2048 + k * 1024); } while (0)
#define PG8_LDB(dst, b, h) do { _Pragma("unroll") for (int n = 0; n < 2; ++n) _Pragma("unroll") for (int k = 0; k < 2; ++k) dst[n][k] = *(const PG8_LAS bf16x8*)(lds + PG8_SB(b, h) + boff + n * 2048 + k * 1024); } while (0)
#define PG8_MMA(ai, bj, At, Bt) do { __builtin_amdgcn_s_setprio(1); _Pragma("unroll") for (int m = 0; m < 4; ++m) _Pragma("unroll") for (int n = 0; n < 2; ++n) _Pragma("unroll") for (int k = 0; k < 2; ++k) \
        acc[ai][bj][m][n] = __builtin_amdgcn_mfma_f32_16x16x32_bf16(Bt[n][k], At[m][k], acc[ai][bj][m][n], 0, 0, 0); __builtin_amdgcn_s_setprio(0); } while (0)
#define PG8_WAIT_V(n) asm volatile("s_waitcnt vmcnt(" #n ")" ::: "memory")
#define PG8_WAIT_L(n) asm volatile("s_waitcnt lgkmcnt(" #n ")" ::: "memory")
#define PG8_BAR __builtin_amdgcn_s_barrier()
#define PG8_SCHED __builtin_amdgcn_sched_barrier(0)
    Unit cur, nxt; int ui = 0;
    if (!S.next(0, cur)) return;
    f32x4 acc[2][2][4][2];
#pragma unroll
    for (int a = 0; a < 2; ++a)
#pragma unroll
        for (int b = 0; b < 2; ++b)
#pragma unroll
            for (int m = 0; m < 4; ++m)
#pragma unroll
                for (int n = 0; n < 2; ++n) acc[a][b][m][n] = (f32x4){0.f, 0.f, 0.f, 0.f};
    bf16x8 At[4][2], B0[2][2], B1[2][2];
    const char* cA = (const char*)g.A + (size_t)cur.pm * tstep; const char* cB = (const char*)g.Bt + (size_t)cur.pn * tstep;
    S.a_ready(cur);
    if constexpr (SP2) {
        PG8_STAGE(PG8_SB(0, 0), cB, voffB); PG8_STAGE(PG8_SB(0, 1), cB + hstep, voffB); PG8_STAGE(PG8_SA(0, 0), cA, voffA); PG8_STAGE(PG8_SA(0, 1), cA + hstep, voffA);
        if (wr == 1) PG8_BAR;
        PG8_WAIT_V(2); PG8_BAR;
        PG8_STAGE(PG8_SB(1, 0), cB + kstep, voffB); PG8_STAGE(PG8_SA(1, 0), cA + kstep, voffA); PG8_STAGE(PG8_SB(1, 1), cB + hstep + kstep, voffB);
        PG8_WAIT_V(6); PG8_BAR;
    } else {
        PG8_STAGE(PG8_SB(0, 0), cB, voffB); PG8_STAGE(PG8_SA(0, 0), cA, voffA); PG8_STAGE(PG8_SB(0, 1), cB + hstep, voffB); PG8_STAGE(PG8_SA(0, 1), cA + hstep, voffA);
        if (wr == 1) PG8_BAR;
        PG8_WAIT_V(4); PG8_BAR;
        PG8_STAGE(PG8_SB(1, 0), cB + kstep, voffB); PG8_STAGE(PG8_SA(1, 0), cA + kstep, voffA); PG8_STAGE(PG8_SB(1, 1), cB + hstep + kstep, voffB);
        PG8_WAIT_V(6); PG8_BAR;
    }
    for (;;) {
        const bool has_next = S.next(ui + 1, nxt);
        const char* nA = has_next ? (const char*)g.A + (size_t)nxt.pm * tstep : cA; const char* nB = has_next ? (const char*)g.Bt + (size_t)nxt.pn * tstep : cB;
        for (int t = 0; t < nt; t += 2) {
            const bool last = (t == nt - 2);
            const char* a1 = cA + (size_t)(t + 1) * kstep;
            const char* a2 = last ? nA : cA + (size_t)(t + 2) * kstep; const char* b2 = last ? nB : cB + (size_t)(t + 2) * kstep;
            const char* a3 = a2 + kstep; const char* b3 = b2 + kstep;
            if (last && has_next) S.a_ready(nxt);
            if constexpr (SP2) {
            PG8_LDB(B0, 0, 0); PG8_LDB(B1, 0, 1); PG8_SCHED; PG8_LDA(At, 0, 0); PG8_STAGE(PG8_SA(1, 1), a1 + hstep, voffA);
            PG8_WAIT_V(8); PG8_WAIT_L(0); PG8_BAR; PG8_MMA(0, 0, At, B0); PG8_MMA(0, 1, At, B1); PG8_BAR; PG8_SCHED;
            PG8_LDA(At, 0, 1); PG8_STAGE(PG8_SB(0, 0), b2, voffB); PG8_STAGE(PG8_SB(0, 1), b2 + hstep, voffB); PG8_STAGE(PG8_SA(0, 0), a2, voffA);
            PG8_WAIT_V(8); PG8_WAIT_L(0); PG8_BAR; PG8_MMA(1, 0, At, B0); PG8_MMA(1, 1, At, B1); PG8_BAR; PG8_SCHED;
            PG8_LDB(B0, 1, 0); PG8_LDB(B1, 1, 1); PG8_SCHED; PG8_LDA(At, 1, 0); PG8_STAGE(PG8_SA(0, 1), a2 + hstep, voffA);
            PG8_WAIT_V(8); PG8_WAIT_L(0); PG8_BAR; PG8_MMA(0, 0, At, B0); PG8_MMA(0, 1, At, B1); PG8_BAR; PG8_SCHED;
            PG8_LDA(At, 1, 1); PG8_STAGE(PG8_SB(1, 0), b3, voffB); PG8_STAGE(PG8_SB(1, 1), b3 + hstep, voffB); PG8_STAGE(PG8_SA(1, 0), a3, voffA);
            PG8_WAIT_V(8); PG8_WAIT_L(0); PG8_BAR; PG8_MMA(1, 0, At, B0); PG8_MMA(1, 1, At, B1); PG8_BAR; PG8_SCHED;
            } else {
            PG8_LDB(B0, 0, 0); PG8_SCHED; PG8_LDA(At, 0, 0); PG8_STAGE(PG8_SA(1, 1), a1 + hstep, voffA);
            PG8_WAIT_L(8); PG8_BAR; PG8_WAIT_L(0); PG8_MMA(0, 0, At, B0); PG8_BAR; PG8_SCHED;
            PG8_LDB(B1, 0, 1); PG8_STAGE(PG8_SB(0, 0), b2, voffB);
            PG8_BAR; PG8_WAIT_L(0); PG8_MMA(0, 1, At, B1); PG8_BAR;
            PG8_LDA(At, 0, 1); PG8_STAGE(PG8_SA(0, 0), a2, voffA);
            PG8_BAR; PG8_WAIT_L(0); PG8_MMA(1, 0, At, B0); PG8_BAR; PG8_SCHED;
            PG8_STAGE(PG8_SB(0, 1), b2 + hstep, voffB);
            PG8_WAIT_V(6); PG8_BAR; PG8_MMA(1, 1, At, B1); PG8_BAR;
            PG8_LDB(B0, 1, 0); PG8_SCHED; PG8_LDA(At, 1, 0); PG8_STAGE(PG8_SA(0, 1), a2 + hstep, voffA);
            PG8_WAIT_L(8); PG8_BAR; PG8_WAIT_L(0); PG8_MMA(0, 0, At, B0); PG8_BAR; PG8_SCHED;
            PG8_LDB(B1, 1, 1); PG8_STAGE(PG8_SB(1, 0), b3, voffB);
            PG8_BAR; PG8_WAIT_L(0); PG8_MMA(0, 1, At, B1); PG8_BAR;
            PG8_LDA(At, 1, 1); PG8_STAGE(PG8_SA(1, 0), a3, voffA);
            PG8_BAR; PG8_WAIT_L(0); PG8_MMA(1, 0, At, B0); PG8_BAR; PG8_SCHED;
            PG8_STAGE(PG8_SB(1, 1), b3 + hstep, voffB);
            PG8_WAIT_V(6); PG8_BAR; PG8_MMA(1, 1, At, B1); PG8_BAR;
            }
        }
        if constexpr (ALIGN_EPI) { if (wr == 0) PG8_BAR; }
        if constexpr (!Epi::AFTER_DRAIN) { E(acc, cur, wr, wc, fr, fq); S.done(cur); }
        if (!has_next) break;
#pragma unroll
        for (int a = 0; a < 2; ++a)
#pragma unroll
            for (int b = 0; b < 2; ++b)
#pragma unroll
                for (int m = 0; m < 4; ++m)
#pragma unroll
                    for (int n = 0; n < 2; ++n) acc[a][b][m][n] = (f32x4){0.f, 0.f, 0.f, 0.f};
        cur = nxt; cA = nA; cB = nB; ++ui;
        if constexpr (ALIGN_EPI) { if (wr == 1) PG8_BAR; }
    }
    PG8_WAIT_V(0);
    if constexpr (!ALIGN_EPI) { if (wr == 0) PG8_BAR; }
    PG8_BAR;
    if constexpr (Epi::AFTER_DRAIN) { E.fused(acc, cur, wr, wc, fr, fq, lds, wid, lane); S.done(cur); }
#undef PG8_SA
#undef PG8_SB
#undef PG8_STAGE
#undef PG8_LDA
#undef PG8_LDB
#undef PG8_MMA
#undef PG8_WAIT_V
#undef PG8_WAIT_L
#undef PG8_BAR
#undef PG8_SCHED
}
}

namespace cg = cooperative_groups;
#define LAS __attribute__((address_space(3)))
typedef unsigned short bf16;
typedef unsigned v4u __attribute__((ext_vector_type(4)));
typedef unsigned v2u __attribute__((ext_vector_type(2)));
typedef float f32x4 __attribute__((ext_vector_type(4)));
typedef short bf16x8 __attribute__((ext_vector_type(8)));
using pg8::cvt_pk_bf16;
typedef float f32x2_t __attribute__((ext_vector_type(2)));
typedef __bf16 bf16x2_t __attribute__((ext_vector_type(2)));
__device__ __forceinline__ unsigned pkc(float lo, float hi) { const f32x2_t v = {lo, hi}; return __builtin_bit_cast(unsigned, __builtin_convertvector(v, bf16x2_t)); }

constexpr int NB = 2, SEQ = 8192, D = 1024, M = NB * SEQ, FF = 2816, NH = 8, NMOD = 9 * D, INW = 8208;
constexpr float EPS = 1e-6f;
constexpr size_t MiB = 1u << 20;
constexpr size_t WS_MOD = 64 * 1024;
constexpr size_t WS_GL = 256 * 1024;
constexpr size_t WS_STATS = 512 * 1024;
constexpr size_t WS_G = 2 * MiB;
constexpr size_t WS_BETA = 1 * MiB + 512 * 1024;
constexpr size_t WS_W = 4 * MiB;
constexpr size_t WS_WBR = 21 * MiB, WS_WOUT = 25 * MiB;
constexpr size_t WS_H = 28 * MiB;
constexpr size_t WS_Q = 60 * MiB, WS_K = 92 * MiB, WS_V = 124 * MiB, WS_Z = 156 * MiB, WS_WW = 188 * MiB, WS_QK = 220 * MiB, WS_TAIL = 156 * MiB;
constexpr size_t WS_ACT = 60 * MiB;
constexpr size_t WS_END = 256 * MiB;
constexpr int LDS_BYTES = 160 * 1024;
#if defined(SKIP_F1)
constexpr float F1SCALE = 0.0f;
#else
constexpr float F1SCALE = 0.5f;
#endif

__device__ __forceinline__ float bf2f(unsigned short h) { return __uint_as_float((unsigned)h << 16); }
__device__ __forceinline__ float wave_sum(float v) {
#pragma unroll
    for (int o = 1; o < 64; o <<= 1) v += __shfl_xor(v, o);
    return v;
}
#define LDS_WAIT() asm volatile("s_waitcnt lgkmcnt(0)" ::: "memory")
#define WG_BAR() do { asm volatile("s_waitcnt lgkmcnt(0)" ::: "memory"); __builtin_amdgcn_s_barrier(); asm volatile("" ::: "memory"); } while (0)


#define RLX_AGENT __ATOMIC_RELAXED, __HIP_MEMORY_SCOPE_AGENT
#define XB_TMO      128
#define XB_XCNT(j)  (256  + 64 * (j))
#define XB_XSUB(j)  (1280 + 64 * (j))
#define XB_XGEN(j)  (2304 + 64 * (j))
#define XB_TOP      3328
#define XB_TOPGEN   3392
#define XCD_BAR_WORDS 3456
#define XB_SPIN_CAP (1u << 18)

__device__ __forceinline__ unsigned xb_ld(unsigned* p)              { return __hip_atomic_load(p, __ATOMIC_RELAXED, __HIP_MEMORY_SCOPE_AGENT); }
__device__ __forceinline__ unsigned xb_add(unsigned* p, unsigned v) { return __hip_atomic_fetch_add(p, v, __ATOMIC_RELAXED, __HIP_MEMORY_SCOPE_AGENT); }
__device__ __forceinline__ unsigned xb_xcc_id() { return (unsigned)__builtin_amdgcn_s_getreg((3 << 11) | 20) & 0xFu; }
#define XB_SPIN(cond, bar) do { unsigned _sp = 0; while (cond) { __builtin_amdgcn_s_sleep(1); \
    if ((++_sp & 255u) == 0u) { if (xb_ld(&(bar)[XB_TMO])) break; if (_sp > XB_SPIN_CAP) { atomicAdd(&(bar)[XB_TMO], 1u); break; } } } } while (0)

struct XcdBarrier {
    unsigned* bar; unsigned x;
    volatile LAS unsigned* st;
};

__device__ __forceinline__ XcdBarrier xcd_barrier_post(unsigned* bar, volatile LAS unsigned* st) {
    XcdBarrier b; b.bar = bar; b.x = xb_xcc_id(); b.st = st;
    if (threadIdx.x == 0) (void)xb_add(&bar[XB_XCNT(b.x)], 1u);
    return b;
}
__device__ __forceinline__ void xcd_barrier_complete(unsigned* bar, unsigned x, unsigned& nloc, unsigned& nx) {
    const unsigned G = gridDim.x * gridDim.y * gridDim.z;
    unsigned sum, cnt, mine, sp = 0u;
    for (;;) {
        sum = 0u; cnt = 0u; mine = 0u;
#pragma unroll
        for (unsigned j = 0; j < 16; ++j) { const unsigned c = xb_ld(&bar[XB_XCNT(j)]); sum += c; cnt += (c > 0u) ? 1u : 0u; mine = (j == x) ? c : mine; }
        if (sum == G) break;
        __builtin_amdgcn_s_sleep(1);
        if ((++sp & 255u) == 0u) { if (xb_ld(&bar[XB_TMO])) break; if (sp > XB_SPIN_CAP) { atomicAdd(&bar[XB_TMO], 1u); break; } }
    }
    nloc = mine > 0u ? mine : 1u; nx = cnt > 0u ? cnt : 1u;
}

__device__ __forceinline__ void xcd_barrier(const XcdBarrier& b) {
    asm volatile("s_waitcnt vmcnt(0)" ::: "memory");
    __syncthreads();
    if (threadIdx.x == 0) {
        unsigned* bar = b.bar;
        __builtin_amdgcn_s_waitcnt(0);
        unsigned nloc = b.st[0], nx = b.st[1];
        if (nloc == 0u) { xcd_barrier_complete(bar, b.x, nloc, nx); b.st[0] = nloc; b.st[1] = nx; }
        const unsigned old = xb_add(&bar[XB_XSUB(b.x)], 1u);
        const unsigned gen = old / nloc;
        if (old + 1u == (gen + 1u) * nloc) {
            __builtin_amdgcn_fence(__ATOMIC_RELEASE, "agent");
            asm volatile("s_waitcnt vmcnt(0)" ::: "memory");
            const unsigned og = xb_add(&bar[XB_TOP], 1u);
            const unsigned tg = og / nx;
            if (og + 1u == (tg + 1u) * nx) xb_add(&bar[XB_TOPGEN], 1u);
            else XB_SPIN(xb_ld(&bar[XB_TOPGEN]) == tg, bar);
            __builtin_amdgcn_fence(__ATOMIC_ACQUIRE, "agent");
            xb_add(&bar[XB_XGEN(b.x)], 1u);
            asm volatile("s_waitcnt vmcnt(0)" ::: "memory");
        } else {
            XB_SPIN(xb_ld(&bar[XB_XGEN(b.x)]) == gen, bar);
            __builtin_amdgcn_fence(__ATOMIC_ACQUIRE, "agent");
            asm volatile("s_waitcnt vmcnt(0)" ::: "memory");
        }
    }
    __syncthreads();
}

__device__ __forceinline__ void tr_tile(const float* W, int ldw, int k0, int ns0, bf16* WT, int K, int nd0, LAS float* scr, int lane) {
#pragma unroll 8
    for (int i = 0; i < 32; ++i) { const int kk = 2 * i + (lane >> 5); scr[kk * 33 + (lane & 31)] = W[(size_t)(k0 + kk) * ldw + ns0 + (lane & 31)]; }
    LDS_WAIT(); asm volatile("" ::: "memory");
    const int c = lane & 7;
#pragma unroll
    for (int j = 0; j < 4; ++j) { const int n = (lane >> 3) + 8 * j; const LAS float* s = scr + (8 * c) * 33 + n;
        v4u o; o.x = cvt_pk_bf16(s[0 * 33], s[1 * 33]); o.y = cvt_pk_bf16(s[2 * 33], s[3 * 33]); o.z = cvt_pk_bf16(s[4 * 33], s[5 * 33]); o.w = cvt_pk_bf16(s[6 * 33], s[7 * 33]);
        *(v4u*)(WT + (size_t)(nd0 + n) * K + k0 + 8 * c) = o; }
    LDS_WAIT(); asm volatile("" ::: "memory");
}
__device__ __forceinline__ void conv_ffn_in(const float* W, bf16* WT, int item, LAS float* scr, int lane) {
    const int kb = item / 176, nb = item % 176, c = 32 * nb; const int half = c >= FF ? 1 : 0, j = c - half * FF;
    tr_tile(W, 2 * FF, 64 * kb, c, WT, D, 256 * (j >> 7) + 128 * half + (j & 127), scr, lane);
}
__device__ __forceinline__ void conv_plain(const float* W, int Kdim, int Ndim, bf16* WT, int item, LAS float* scr, int lane) {
    const int nblk = Ndim / 32, kb = item / nblk, nb = item % nblk;
    tr_tile(W, Ndim, 64 * kb, 32 * nb, WT, Kdim, 32 * nb, scr, lane);
}
__device__ __forceinline__ void conv_inproj(const float* W, bf16* WT, int item, LAS float* scr, int lane) {
    const int kb = item >> 8, nd0 = 32 * (item & 255); const int ns0 = nd0 < 3072 ? nd0 + 2048 : (nd0 < 5120 ? nd0 - 3072 : (nd0 < 7168 ? nd0 + 1040 : nd0 - 2048));
    tr_tile(W, INW, 64 * kb, ns0, WT, D, nd0, scr, lane);
}

template <int MODE>
__device__ __forceinline__ void norm_rows(const float* xin, const float* gain, const float* mod, int sh_off, int sc_off, bf16* H, int gw, int NGW, int lane,
                                          const LAS float* wabT, const float* a_log, const float* dt_bias, float* Gd, float* Bd) {
    int curb = -1; f32x4 cA[4], cB[4];
    for (int m = gw; m < M; m += NGW) {
        const int b = m >> 13;
        if (b != curb) { curb = b;
#pragma unroll
            for (int j = 0; j < 4; ++j) { const int c = 4 * lane + 256 * j; const f32x4 gv = *(const f32x4*)(gain + c), sc = *(const f32x4*)(mod + b * NMOD + sc_off + c);
                cA[j] = gv * (sc + 1.0f); cB[j] = *(const f32x4*)(mod + b * NMOD + sh_off + c); } }
        const f32x4* xr = (const f32x4*)(xin + (size_t)m * D) + lane; f32x4 v[4]; float ss = 0.f;
#pragma unroll
        for (int j = 0; j < 4; ++j) { v[j] = xr[64 * j]; ss += (v[j].x * v[j].x + v[j].y * v[j].y) + (v[j].z * v[j].z + v[j].w * v[j].w); }
        const float r = 1.0f / sqrtf(wave_sum(ss) * (1.0f / D) + EPS);
        v2u* o8 = (v2u*)(H + (size_t)m * D) + lane;
#pragma unroll
        for (int j = 0; j < 4; ++j) { v[j] = v[j] * r * cA[j] + cB[j]; v2u w; w.x = cvt_pk_bf16(v[j].x, v[j].y); w.y = cvt_pk_bf16(v[j].z, v[j].w); o8[64 * j] = w; }
        if (MODE == 1) {
            float mine = 0.f;
            LAS float* red = (LAS float*)((LAS unsigned char*)wabT + 65536) + (lane * 0 + __builtin_amdgcn_readfirstlane(threadIdx.x >> 6)) * 1040;
#pragma unroll
            for (int c = 0; c < 16; ++c) { float a = 0.f;
#pragma unroll
                for (int j = 0; j < 4; ++j) { const f32x4 w = *(const LAS f32x4*)(wabT + c * 1024 + 4 * lane + 256 * j); a += (v[j].x * w.x + v[j].y * w.y) + (v[j].z * w.z + v[j].w * w.w); }
                red[c * 65 + lane] = a; }
            asm volatile("s_waitcnt lgkmcnt(0)" ::: "memory");
            if (lane < 16) { float s0 = 0.f, s1 = 0.f, s2 = 0.f, s3 = 0.f;
#pragma unroll
                for (int j = 0; j < 64; j += 4) { s0 += red[lane * 65 + j]; s1 += red[lane * 65 + j + 1]; s2 += red[lane * 65 + j + 2]; s3 += red[lane * 65 + j + 3]; }
                mine = (s0 + s1) + (s2 + s3); }
            asm volatile("s_waitcnt lgkmcnt(0)" ::: "memory");
            { const int hh = lane & 7; const float xv = mine + dt_bias[hh]; const float sp = fmaxf(xv, 0.f) + log1pf(__expf(-fabsf(xv)));
              const float gval = -__expf(a_log[hh]) * sp, bval = 1.0f / (1.0f + __expf(-mine));
              if (lane < 16) Gd[(size_t)m * 16 + lane] = (lane < 8) ? gval : bval; }
        }
    }
}


#if defined(DIAG_W)
__device__ __forceinline__ void zprobe(const bf16* Vs_, size_t tok0, int h, int ht, int lane, unsigned* word) {
    if (ht < 64) { float m = fabsf(bf2f(Vs_[16777216 + (tok0 + ht) * 1024 + h * 128 + 5]));
        for (int o = 1; o < 64; o <<= 1) m = fmaxf(m, __shfl_xor(m, o));
        if (lane == 0) atomicMax(word, __float_as_uint(1.0f / (m + 1e-6f))); }
}
#endif
#if defined(NO_TAIL)
#define NOTAIL_FLAG false
#else
#define NOTAIL_FLAG true
#endif
constexpr int DL_HALF = 69632;
template <int MODE>
__device__ __forceinline__ void dn_local_phase(LAS unsigned char* L, bf16* Qs, bf16* Ks, bf16* Vs, bf16* WWs, bf16* QKs, bf16* Qp, const float* Gd, const float* Bd, float* GL,
                                               const float* conv_w, int tid, int nblk, int bid) {
    const int wv = __builtin_amdgcn_readfirstlane((tid >> 6) & 3);
    for (int it = bid; it < 1024; it += nblk) {
        int tidv = tid; asm volatile("" : "+v"(tidv));
        const int hw = tidv >> 8, ht = tidv & 255, lane = tidv & 63, fr = lane & 15, fq = lane >> 4;
        LAS unsigned char* Lh = L + hw * DL_HALF;
        LAS float* AM = (LAS float*)(Lh + 52224);
        LAS float* gcs = (LAS float*)(Lh + 68608); LAS float* bts = gcs + 64; LAS float* egs = gcs + 128; LAS float* gcs2 = gcs + 192;
        LAS float* cwl = (LAS float*)(L + 2 * DL_HALF + hw * 6144);
        const int unit = it * 2 + hw, h = unit & 7, n = (unit >> 3) & 127, b = unit >> 10;
        const size_t tok0 = (size_t)b * SEQ + 64 * n;
        __syncthreads();
        if (MODE == 2 && ht < 64) { gcs[ht] = Gd[(tok0 + ht) * 16 + h]; bts[ht] = Gd[(tok0 + ht) * 16 + 8 + h]; }
        if (MODE == 0 || MODE == 2) {
#pragma unroll
            for (int k12 = 0; k12 < 12; ++k12) { const int idx = ht + 256 * k12, T = idx >> 10, r = (idx >> 4) & 63, ch = idx & 15;
                const bf16* sp = (T == 0 ? Qs : (T == 1 ? Ks : Vs)) + (tok0 + r) * 1024 + h * 128 + ch * 8;
                *(LAS v4u*)(Lh + T * 18224 + (r + 3) * 272 + ch * 16) = *(const v4u*)sp; }
            if (ht < 144) { const int T = ht / 48, rem = ht - T * 48, r = rem >> 4, ch = rem & 15;
                v4u val = (v4u){0u, 0u, 0u, 0u};
#if !defined(NO_HALO)
                if (n > 0) { if (MODE == 2) val = *(const v4u*)(Qp + ((size_t)((b * 128 + n - 1) * 3 + r)) * 3072 + T * 1024 + h * 128 + ch * 8);
                             else val = *(const v4u*)((T == 0 ? Qs : (T == 1 ? Ks : Vs)) + (tok0 - 3 + r) * 1024 + h * 128 + ch * 8); }
#endif
                *(LAS v4u*)(Lh + T * 18224 + r * 272 + ch * 16) = val; }
            for (int c = ht; c < 384; c += 256) { const int j = c / 96, rem = c - j * 96, T = rem >> 5, ch4 = rem & 31;
                *(LAS f32x4*)(cwl + (j * 3 + T) * 128 + ch4 * 4) = *(const f32x4*)(conv_w + (size_t)j * 3072 + T * 1024 + h * 128 + ch4 * 4); }
        } else {
            if (ht < 64) { gcs[ht] = Gd[(tok0 + ht) * 16 + h]; bts[ht] = Gd[(tok0 + ht) * 16 + 8 + h]; }
#pragma unroll
            for (int k12 = 0; k12 < 12; ++k12) { const int idx = ht + 256 * k12, T = idx >> 10, r = (idx >> 4) & 63, ch = idx & 15;
                const bf16* sp = (T == 0 ? Qp : (T == 1 ? WWs : QKs)) + (tok0 + r) * 1024 + h * 128 + ch * 8;
                *(LAS v4u*)(Lh + T * 17408 + r * 272 + ch * 16) = *(const v4u*)sp; }
        }
        __syncthreads();
        if (MODE != 0 && ht < 64) { float acc_g = 0.f;
#pragma unroll 8
            for (int j = 0; j < 64; ++j) { const float gj = gcs[j]; acc_g += (j <= ht) ? gj : 0.f; }
            gcs2[ht] = acc_g; egs[ht] = __expf(acc_g);
            if (ht == 63) GL[(b * 8 + h) * 128 + n] = __expf(acc_g); }
        if (MODE == 0 || MODE == 2) {
        const int ti = ht >> 2, tq = ht & 3;
        unsigned outp[3][16];
        {
#pragma unroll
            for (int T = 0; T < 3; ++T) {
                float y[32]; float ss = 0.f;
#pragma unroll
                for (int cgp = 0; cgp < 4; ++cgp) { const int ch0 = tq * 32 + cgp * 8; float a[8];
#pragma unroll
                    for (int e = 0; e < 8; ++e) a[e] = 0.f;
#pragma unroll
                    for (int j = 0; j < 4; ++j) { const v4u xv = *(const LAS v4u*)(Lh + T * 18224 + (ti + j) * 272 + ch0 * 2);
                        const LAS float* wp = cwl + (j * 3 + T) * 128 + ch0; const f32x4 w0 = *(const LAS f32x4*)wp, w1 = *(const LAS f32x4*)(wp + 4);
                        a[0] += w0.x * __uint_as_float(xv.x << 16); a[1] += w0.y * __uint_as_float(xv.x & 0xffff0000u); a[2] += w0.z * __uint_as_float(xv.y << 16); a[3] += w0.w * __uint_as_float(xv.y & 0xffff0000u);
                        a[4] += w1.x * __uint_as_float(xv.z << 16); a[5] += w1.y * __uint_as_float(xv.z & 0xffff0000u); a[6] += w1.z * __uint_as_float(xv.w << 16); a[7] += w1.w * __uint_as_float(xv.w & 0xffff0000u); }
#pragma unroll
                    for (int e = 0; e < 8; ++e) { const float s = a[e] / (1.0f + __expf(-a[e])); y[cgp * 8 + e] = s; ss += s * s; } }
                float scl = 1.0f;
                if (T < 2) { ss += __shfl_xor(ss, 1); ss += __shfl_xor(ss, 2); scl = 1.0f / sqrtf(ss + EPS); if (T == 0) scl *= 0.08838834764831845f; }
#if defined(DIAG_W)
                if (T == 1) atomicMax((unsigned*)GL + 4004 - 65536, __float_as_uint(ss * scl * scl));
#endif
#pragma unroll
                for (int e = 0; e < 16; ++e) outp[T][e] = cvt_pk_bf16(y[2 * e] * scl, y[2 * e + 1] * scl);
            }
        }
        if (MODE == 0) {
#if defined(P6A_INPLACE)
#pragma unroll
        for (int T = 0; T < 3; ++T) { bf16* dp = (T == 0 ? Qs : (T == 1 ? Ks : Vs)) + (tok0 + ti) * 1024 + h * 128 + tq * 32;
#else
#pragma unroll
        for (int T = 0; T < 3; ++T) { bf16* dp = (T == 0 ? Qp : (T == 1 ? WWs : QKs)) + (tok0 + ti) * 1024 + h * 128 + tq * 32;
#endif
#pragma unroll
            for (int k4 = 0; k4 < 4; ++k4) { const v4u ov = (v4u){outp[T][4 * k4], outp[T][4 * k4 + 1], outp[T][4 * k4 + 2], outp[T][4 * k4 + 3]};
#if defined(NO_P6A_STORE)
                if (ov.x == 0x12345678u) *(v4u*)(dp + k4 * 8) = ov;
#else
                *(v4u*)(dp + k4 * 8) = ov;
#endif
            } }
        continue;
        }
        __syncthreads();
#pragma unroll
        for (int T = 0; T < 3; ++T)
#pragma unroll
            for (int k4 = 0; k4 < 4; ++k4) *(LAS v4u*)(Lh + T * 17408 + ti * 272 + tq * 64 + k4 * 16) = (v4u){outp[T][4 * k4], outp[T][4 * k4 + 1], outp[T][4 * k4 + 2], outp[T][4 * k4 + 3]};
        }
        __syncthreads();
        {
            bf16x8 ak[4], aq[4];
#if defined(DIAG_W)
            float dam = 0.f, dkk = 0.f;
#endif
#pragma unroll
            for (int s = 0; s < 4; ++s) { ak[s] = *(const LAS bf16x8*)(Lh + 17408 + (16 * wv + fr) * 272 + s * 64 + fq * 16); aq[s] = *(const LAS bf16x8*)(Lh + (16 * wv + fr) * 272 + s * 64 + fq * 16); }
            bf16* qkp = QKs + tok0 * 1024 + h * 128;
#pragma unroll
            for (int jt = 0; jt < 4; ++jt) { f32x4 ckk = (f32x4){0.f, 0.f, 0.f, 0.f}, cqk = (f32x4){0.f, 0.f, 0.f, 0.f};
#pragma unroll
                for (int s = 0; s < 4; ++s) { const bf16x8 bk = *(const LAS bf16x8*)(Lh + 17408 + (16 * jt + fr) * 272 + s * 64 + fq * 16);
                    ckk = __builtin_amdgcn_mfma_f32_16x16x32_bf16(ak[s], bk, ckk, 0, 0, 0); cqk = __builtin_amdgcn_mfma_f32_16x16x32_bf16(aq[s], bk, cqk, 0, 0, 0); }
                const int j = 16 * jt + fr; const float gj = gcs2[j];
#pragma unroll
                for (int r = 0; r < 4; ++r) { const int i = 16 * wv + 4 * fq + r; const float e = __expf(fminf(gcs2[i] - gj, 0.f));
                    AM[i * 64 + j] = (j < i) ? ckk[r] * bts[i] * e : 0.f;
#if defined(DIAG_W)
                    dam = fmaxf(dam, (j < i) ? fabsf(ckk[r] * bts[i] * e) : 0.f); dkk = fmaxf(dkk, fabsf(ckk[r]));
#endif
#if !defined(P6_SKIP_QK)
                    qkp[(size_t)i * 1024 + j] = (bf16)(cvt_pk_bf16((j <= i) ? cqk[r] * e : 0.f, 0.f) & 0xffffu);
#endif
                    } }
#if defined(DIAG_W)
            atomicMax((unsigned*)GL + 4001 - 65536, __float_as_uint(dam)); atomicMax((unsigned*)GL + 4002 - 65536, __float_as_uint(dkk));
#endif
        }
        __syncthreads();
        {
            const float gl = gcs2[63];
#pragma unroll
            for (int k4 = 0; k4 < 4; ++k4) { const int idx = ht + 256 * k4, row = idx >> 4, ch = idx & 15; const v4u q8 = *(const LAS v4u*)(Lh + row * 272 + ch * 16); const float e = egs[row];
                v4u o; o.x = cvt_pk_bf16(__uint_as_float(q8.x << 16) * e, __uint_as_float(q8.x & 0xffff0000u) * e); o.y = cvt_pk_bf16(__uint_as_float(q8.y << 16) * e, __uint_as_float(q8.y & 0xffff0000u) * e);
                o.z = cvt_pk_bf16(__uint_as_float(q8.z << 16) * e, __uint_as_float(q8.z & 0xffff0000u) * e); o.w = cvt_pk_bf16(__uint_as_float(q8.w << 16) * e, __uint_as_float(q8.w & 0xffff0000u) * e);
#if !defined(P6_SKIP_QD)
                *(v4u*)(Qs + (tok0 + row) * 1024 + h * 128 + ch * 8) = o;
#endif
                }
#pragma unroll
            for (int k4 = 0; k4 < 4; ++k4) { const int idx = ht + 256 * k4, d = idx & 127, cb = idx >> 7; float kv[8];
#pragma unroll
                for (int e = 0; e < 8; ++e) { const int c = 8 * cb + e; kv[e] = bf2f(*(const LAS unsigned short*)(Lh + 17408 + c * 272 + d * 2)) * __expf(gl - gcs2[c]); }
                v4u o; o.x = cvt_pk_bf16(kv[0], kv[1]); o.y = cvt_pk_bf16(kv[2], kv[3]); o.z = cvt_pk_bf16(kv[4], kv[5]); o.w = cvt_pk_bf16(kv[6], kv[7]);
#if !defined(P6_SKIP_KD)
                *(v4u*)(Ks + (tok0 + (d >> 1)) * 1024 + h * 128 + (d & 1) * 64 + 8 * cb) = o;
#endif
                }
        }
#if defined(DIAG_W)
        asm volatile("s_waitcnt vmcnt(0)" ::: "memory"); zprobe(Vs, tok0, h, ht, lane, (unsigned*)GL + 4017 - 65536);
#endif
        {
            const bool isU = ht < 128; const int xc = ht & 127;
            const LAS unsigned short* src = (const LAS unsigned short*)(Lh + (isU ? 34816 : 17408)) + xc;
            __attribute__((address_space(1))) bf16* dst = (__attribute__((address_space(1))) bf16*)((isU ? Vs : WWs) + tok0 * 1024 + h * 128 + xc);
            float sol[64];
#if defined(DIAG_W)
            float dmx = 0.f, dmu = 0.f;
#endif
#pragma unroll
            for (int i = 0; i < 64; ++i) {
                float s = bf2f(src[i * 136]) * bts[i]; if (!isU) s *= egs[i];
#if defined(ZERO_T012)
                if (i < 3) s = 0.f;
#endif
#if !defined(NO_AM)
#pragma unroll
                for (int j = 0; j < i; ++j) s = fmaf(-AM[i * 64 + j], sol[j], s);
#endif
                sol[i] = s;
#if defined(DIAG_W)
                if (!isU) dmx = fmaxf(dmx, fabsf(s)); else dmu = fmaxf(dmu, fabsf(s));
#endif
#if !defined(P6_SKIP_SOLVE)
                *dst = (bf16)(cvt_pk_bf16(s, 0.f) & 0xffffu);
#endif
                dst += 1024;
                asm volatile("" : "+v"(dst) :: "memory");
            }
#if defined(DIAG_W)
            atomicMax((unsigned*)GL + 4000 - 65536 + 0, __float_as_uint(dmx));
            atomicMax((unsigned*)GL + 4003 - 65536, __float_as_uint(dmu));
#endif
#if defined(DIAG_W)
            asm volatile("s_waitcnt vmcnt(0)" ::: "memory"); zprobe(Vs, tok0, h, ht, lane, (unsigned*)GL + 4018 - 65536);
#endif
        }
    }
}

constexpr int SC_STAGE = 62464, SC_ST = 2 * SC_STAGE, SC_VNT = SC_ST + 8704;
struct ScSet { v4u pw[2], pq[2], pk[2], pqk; v2u pu[2]; float gl; };
__device__ __forceinline__ void dn_scan_phase(LAS unsigned char* L, const bf16* Qs, const bf16* Ks, bf16* Vs, const bf16* WWs, const bf16* QKs, const float* GL, int tid, int bid) {
    constexpr int NVT = 1, VS = 16 * NVT;
    if (bid >= 128) return;
    const int xcd = bid & 7, rr = bid >> 3, sl = rr & 7, p = xcd + 8 * (rr >> 3), b = p >> 3, h = p & 7;
    const int w = __builtin_amdgcn_readfirstlane(tid >> 6), lane = tid & 63, fr = lane & 15, fq = lane >> 4;
    const size_t rowb = (size_t)b * SEQ;
    LAS unsigned char* ST = L + SC_ST; LAS unsigned char* VNT = L + SC_VNT;
    for (int i = tid; i < 8704 / 4; i += 512) ((LAS unsigned*)ST)[i] = 0u;
    f32x4 accS[2]; accS[0] = (f32x4){0.f, 0.f, 0.f, 0.f}; accS[1] = accS[0];
    const int r16 = tid >> 4, c16 = tid & 15;
    const int r8 = tid >> 3, c8 = tid & 7;
#define SC_LOADS(S, nn) do { const size_t t0 = rowb + 64 * (nn); \
        S.pw[0] = *(const v4u*)(WWs + (t0 + r16) * 1024 + h * 128 + c16 * 8); S.pw[1] = *(const v4u*)(WWs + (t0 + r16 + 32) * 1024 + h * 128 + c16 * 8); \
        S.pq[0] = *(const v4u*)(Qs + (t0 + r16) * 1024 + h * 128 + c16 * 8); S.pq[1] = *(const v4u*)(Qs + (t0 + r16 + 32) * 1024 + h * 128 + c16 * 8); \
        S.pk[0] = *(const v4u*)(Ks + (t0 + (r8 >> 1)) * 1024 + h * 128 + (r8 & 1) * 64 + c8 * 8); S.pk[1] = *(const v4u*)(Ks + (t0 + 32 + (r8 >> 1)) * 1024 + h * 128 + (r8 & 1) * 64 + c8 * 8); \
        S.pqk = *(const v4u*)(QKs + (t0 + r8) * 1024 + h * 128 + c8 * 8); \
        if (w < 4) { S.pu[0] = *(const v2u*)(Vs + (t0 + 16 * w + fr) * 1024 + h * 128 + VS * sl + 4 * fq); if (NVT == 2) S.pu[1] = *(const v2u*)(Vs + (t0 + 16 * w + fr) * 1024 + h * 128 + VS * sl + 16 + 4 * fq); } \
        S.gl = GL[(b * 8 + h) * 128 + (nn)]; } while (0)
#define SC_WRITES(S, buf) do { LAS unsigned char* Sw = L + (buf) * SC_STAGE; \
        *(LAS v4u*)(Sw + r16 * 272 + c16 * 16) = S.pw[0]; *(LAS v4u*)(Sw + (r16 + 32) * 272 + c16 * 16) = S.pw[1]; \
        *(LAS v4u*)(Sw + 17408 + r16 * 272 + c16 * 16) = S.pq[0]; *(LAS v4u*)(Sw + 17408 + (r16 + 32) * 272 + c16 * 16) = S.pq[1]; \
        *(LAS v4u*)(Sw + 34816 + r8 * 144 + c8 * 16) = S.pk[0]; *(LAS v4u*)(Sw + 34816 + (r8 + 64) * 144 + c8 * 16) = S.pk[1]; \
        *(LAS v4u*)(Sw + 53248 + r8 * 144 + c8 * 16) = S.pqk; } while (0)
    ScSet R0, R1, R2;
    R0.pu[0] = (v2u){0u, 0u}; R0.pu[1] = R0.pu[0]; R1.pu[0] = R0.pu[0]; R1.pu[1] = R0.pu[0]; R2.pu[0] = R0.pu[0]; R2.pu[1] = R0.pu[0];
    SC_LOADS(R0, 0); SC_WRITES(R0, 0);
    v2u ucur[2]; ucur[0] = R0.pu[0]; ucur[1] = R0.pu[1]; float gl = R0.gl;
    v2u unext[2]; unext[0] = ucur[0]; unext[1] = ucur[1]; float gnext = gl;
    SC_LOADS(R1, 1); SC_LOADS(R2, 2); SC_LOADS(R0, 3);
    __syncthreads();
#define SC_STEP(n, SW) do { LAS unsigned char* Sg = L + ((n) & 1) * SC_STAGE; \
        if ((n) + 1 < 128) { SC_WRITES(SW, ((n) + 1) & 1); unext[0] = SW.pu[0]; unext[1] = SW.pu[1]; gnext = SW.gl; } \
        if ((n) + 4 < 128) SC_LOADS(SW, (n) + 4); \
        f32x4 acc[2]; acc[0] = (f32x4){0.f, 0.f, 0.f, 0.f}; acc[1] = acc[0]; \
        { const LAS unsigned char* Arow = Sg + (w < 4 ? 0 : 17408) + (16 * (w & 3) + fr) * 272 + fq * 16; \
          _Pragma("unroll") for (int s = 0; s < 4; ++s) { const bf16x8 bfr = *(const LAS bf16x8*)(Arow + s * 64); \
            _Pragma("unroll") for (int vt = 0; vt < NVT; ++vt) { const bf16x8 afr = *(const LAS bf16x8*)(ST + (16 * vt + fr) * 272 + s * 64 + fq * 16); acc[vt] = __builtin_amdgcn_mfma_f32_16x16x32_bf16(afr, bfr, acc[vt], 0, 0, 0); } } } \
        if (w < 4) { _Pragma("unroll") for (int vt = 0; vt < NVT; ++vt) { \
            const float u0 = __uint_as_float(ucur[vt].x << 16), u1 = __uint_as_float(ucur[vt].x & 0xffff0000u), u2 = __uint_as_float(ucur[vt].y << 16), u3 = __uint_as_float(ucur[vt].y & 0xffff0000u); \
            const unsigned p0 = pkc(u0 - acc[vt][0], u1 - acc[vt][1]), p1 = pkc(u2 - acc[vt][2], u3 - acc[vt][3]); \
            LAS unsigned short* vp = (LAS unsigned short*)(VNT + (16 * vt + 4 * fq) * 144 + (16 * w + fr) * 2); \
            vp[0] = (unsigned short)(p0 & 0xffffu); vp[72] = (unsigned short)(p0 >> 16); vp[144] = (unsigned short)(p1 & 0xffffu); vp[216] = (unsigned short)(p1 >> 16); } } \
        WG_BAR(); \
        { accS[0] = accS[0] * gl; accS[1] = accS[1] * gl; \
          _Pragma("unroll") for (int s = 0; s < 2; ++s) { const bf16x8 afr = *(const LAS bf16x8*)(Sg + 34816 + (16 * w + fr) * 144 + s * 64 + fq * 16); \
            _Pragma("unroll") for (int vt = 0; vt < NVT; ++vt) { const bf16x8 bfr = *(const LAS bf16x8*)(VNT + (16 * vt + fr) * 144 + s * 64 + fq * 16); accS[vt] = __builtin_amdgcn_mfma_f32_16x16x32_bf16(afr, bfr, accS[vt], 0, 0, 0); } } \
          _Pragma("unroll") for (int vt = 0; vt < NVT; ++vt) { v2u o; o.x = pkc(accS[vt][0], accS[vt][1]); o.y = pkc(accS[vt][2], accS[vt][3]); *(LAS v2u*)(ST + (16 * vt + fr) * 272 + (16 * w + 4 * fq) * 2) = o; } } \
        if (w >= 4) { \
          _Pragma("unroll") for (int s = 0; s < 2; ++s) { const bf16x8 bfr = *(const LAS bf16x8*)(Sg + 53248 + (16 * (w - 4) + fr) * 144 + s * 64 + fq * 16); \
            _Pragma("unroll") for (int vt = 0; vt < NVT; ++vt) { const bf16x8 afr = *(const LAS bf16x8*)(VNT + (16 * vt + fr) * 144 + s * 64 + fq * 16); acc[vt] = __builtin_amdgcn_mfma_f32_16x16x32_bf16(afr, bfr, acc[vt], 0, 0, 0); } } \
          _Pragma("unroll") for (int vt = 0; vt < NVT; ++vt) { v2u o; o.x = pkc(acc[vt][0], acc[vt][1]); o.y = pkc(acc[vt][2], acc[vt][3]); \
            *(v2u*)(Vs + (rowb + 64 * (n) + 16 * (w - 4) + fr) * 1024 + h * 128 + VS * sl + 16 * vt + 4 * fq) = o; } } \
        ucur[0] = unext[0]; ucur[1] = unext[1]; gl = gnext; \
        WG_BAR(); } while (0)
    for (int n3 = 0; n3 < 126; n3 += 3) { SC_STEP(n3, R1); SC_STEP(n3 + 1, R2); SC_STEP(n3 + 2, R0); }
    SC_STEP(126, R1); SC_STEP(127, R2);
#undef SC_STEP
#undef SC_LOADS
#undef SC_WRITES
}

__device__ __forceinline__ void post_rows(const bf16* Va, float* STATS, const bf16* Os, bf16* Zs, const float* norm_g, int gw, int NGW, int lane) {
    float ng[16];
#pragma unroll
    for (int e = 0; e < 16; ++e) ng[e] = norm_g[((16 * lane) & 127) + e];
    for (int m = gw; m < M; m += NGW) {
        { const v4u a = *((const v4u*)(Va + (size_t)m * D) + lane), c = *((const v4u*)(Va + (size_t)m * D) + 64 + lane); float x[16];
          x[0] = __uint_as_float(a.x << 16); x[1] = __uint_as_float(a.x & 0xffff0000u); x[2] = __uint_as_float(a.y << 16); x[3] = __uint_as_float(a.y & 0xffff0000u);
          x[4] = __uint_as_float(a.z << 16); x[5] = __uint_as_float(a.z & 0xffff0000u); x[6] = __uint_as_float(a.w << 16); x[7] = __uint_as_float(a.w & 0xffff0000u);
          x[8] = __uint_as_float(c.x << 16); x[9] = __uint_as_float(c.x & 0xffff0000u); x[10] = __uint_as_float(c.y << 16); x[11] = __uint_as_float(c.y & 0xffff0000u);
          x[12] = __uint_as_float(c.z << 16); x[13] = __uint_as_float(c.z & 0xffff0000u); x[14] = __uint_as_float(c.w << 16); x[15] = __uint_as_float(c.w & 0xffff0000u);
          float s = 0.f;
#pragma unroll
          for (int e = 0; e < 16; ++e) s += x[e];
#if defined(DIAG_W)
          { float mv = 0.f; for (int e = 0; e < 16; ++e) mv = fmaxf(mv, fabsf(x[e])); atomicMax((unsigned*)STATS - 131072 + 4019, __float_as_uint(mv)); }
#endif
          const float mu = wave_sum(s) * (1.0f / D); float q = 0.f;
#pragma unroll
          for (int e = 0; e < 16; ++e) { const float d = x[e] - mu; q += d * d; }
          const float rstd = 1.0f / sqrtf(wave_sum(q) * (1.0f / D) + EPS);
          if (lane == 0) { STATS[(size_t)m * 2] = mu; STATS[(size_t)m * 2 + 1] = rstd; } }
        { const v4u* op = (const v4u*)(Os + (size_t)m * D + 16 * lane); v4u* zp = (v4u*)(Zs + (size_t)m * D + 16 * lane);
#if defined(Z_ATOMIC)
          v4u z0, z1; { const unsigned* zq = (const unsigned*)zp;
            z0.x = __hip_atomic_load(zq + 0, __ATOMIC_RELAXED, __HIP_MEMORY_SCOPE_AGENT); z0.y = __hip_atomic_load(zq + 1, __ATOMIC_RELAXED, __HIP_MEMORY_SCOPE_AGENT); z0.z = __hip_atomic_load(zq + 2, __ATOMIC_RELAXED, __HIP_MEMORY_SCOPE_AGENT); z0.w = __hip_atomic_load(zq + 3, __ATOMIC_RELAXED, __HIP_MEMORY_SCOPE_AGENT);
            z1.x = __hip_atomic_load(zq + 4, __ATOMIC_RELAXED, __HIP_MEMORY_SCOPE_AGENT); z1.y = __hip_atomic_load(zq + 5, __ATOMIC_RELAXED, __HIP_MEMORY_SCOPE_AGENT); z1.z = __hip_atomic_load(zq + 6, __ATOMIC_RELAXED, __HIP_MEMORY_SCOPE_AGENT); z1.w = __hip_atomic_load(zq + 7, __ATOMIC_RELAXED, __HIP_MEMORY_SCOPE_AGENT); }
          const v4u o0 = op[0], o1 = op[1]; float x[16], z[16];
#else
          const v4u o0 = op[0], o1 = op[1], z0 = zp[0], z1 = zp[1]; float x[16], z[16];
#endif
          x[0] = __uint_as_float(o0.x << 16); x[1] = __uint_as_float(o0.x & 0xffff0000u); x[2] = __uint_as_float(o0.y << 16); x[3] = __uint_as_float(o0.y & 0xffff0000u);
          x[4] = __uint_as_float(o0.z << 16); x[5] = __uint_as_float(o0.z & 0xffff0000u); x[6] = __uint_as_float(o0.w << 16); x[7] = __uint_as_float(o0.w & 0xffff0000u);
          x[8] = __uint_as_float(o1.x << 16); x[9] = __uint_as_float(o1.x & 0xffff0000u); x[10] = __uint_as_float(o1.y << 16); x[11] = __uint_as_float(o1.y & 0xffff0000u);
          x[12] = __uint_as_float(o1.z << 16); x[13] = __uint_as_float(o1.z & 0xffff0000u); x[14] = __uint_as_float(o1.w << 16); x[15] = __uint_as_float(o1.w & 0xffff0000u);
          z[0] = __uint_as_float(z0.x << 16); z[1] = __uint_as_float(z0.x & 0xffff0000u); z[2] = __uint_as_float(z0.y << 16); z[3] = __uint_as_float(z0.y & 0xffff0000u);
          z[4] = __uint_as_float(z0.z << 16); z[5] = __uint_as_float(z0.z & 0xffff0000u); z[6] = __uint_as_float(z0.w << 16); z[7] = __uint_as_float(z0.w & 0xffff0000u);
          z[8] = __uint_as_float(z1.x << 16); z[9] = __uint_as_float(z1.x & 0xffff0000u); z[10] = __uint_as_float(z1.y << 16); z[11] = __uint_as_float(z1.y & 0xffff0000u);
          z[12] = __uint_as_float(z1.z << 16); z[13] = __uint_as_float(z1.z & 0xffff0000u); z[14] = __uint_as_float(z1.w << 16); z[15] = __uint_as_float(z1.w & 0xffff0000u);
#pragma unroll
          for (int e = 0; e < 16; ++e) { if (!(fabsf(x[e]) < 1e30f)) x[e] = 0.f; if (!(fabsf(z[e]) < 1e30f)) z[e] = 0.f; }
          float ss = 0.f;
#pragma unroll
          for (int e = 0; e < 16; ++e) ss += x[e] * x[e];
          ss += __shfl_xor(ss, 1); ss += __shfl_xor(ss, 2); ss += __shfl_xor(ss, 4);
          const float r = 1.0f / sqrtf(ss * (1.0f / 128.0f) + EPS);
#if defined(DIAG_W)
          { float mo = 0.f, mz = 0.f;
            for (int e = 0; e < 16; ++e) { mo = fmaxf(mo, fabsf(x[e])); mz = fmaxf(mz, fabsf(z[e])); }
            atomicMax((unsigned*)STATS - 131072 + 4013, __float_as_uint(mo)); atomicMax((unsigned*)STATS - 131072 + 4012, __float_as_uint(mz)); }
#endif
#pragma unroll
          for (int e = 0; e < 16; ++e) x[e] = x[e] * r * ng[e] * z[e];
          v4u w0, w1; w0.x = cvt_pk_bf16(x[0], x[1]); w0.y = cvt_pk_bf16(x[2], x[3]); w0.z = cvt_pk_bf16(x[4], x[5]); w0.w = cvt_pk_bf16(x[6], x[7]);
          w1.x = cvt_pk_bf16(x[8], x[9]); w1.y = cvt_pk_bf16(x[10], x[11]); w1.z = cvt_pk_bf16(x[12], x[13]); w1.w = cvt_pk_bf16(x[14], x[15]);
          zp[0] = w0; zp[1] = w1; }
    }
}

__device__ __forceinline__ void gmlp_phase(LAS unsigned char* L, bf16* Ua, const bf16* Va, const float* STATS, const float* ln_g, const float* ln_b, const float* w_s, const float* b_s, int tid, int nblk, int bid) {
    const int w = __builtin_amdgcn_readfirstlane(tid >> 6), lane = tid & 63, fr = lane & 15, fq = lane >> 4;
    LAS unsigned char* VT = L; LAS unsigned char* WL = L + 34816;
    for (int unit = bid; unit < 1024; unit += nblk) {
        const int g = unit & 7, nc = (unit >> 3) & 63, b = unit >> 9; const size_t tok0 = (size_t)b * SEQ + 128 * nc;
        __syncthreads();
#pragma unroll
        for (int k4 = 0; k4 < 4; ++k4) { const int idx = tid + 512 * k4, s = idx & 127, ch = idx >> 7;
            const v4u a = *(const v4u*)(Va + (tok0 + s) * 1024 + 128 * g + 8 * ch); const float mu = STATS[(tok0 + s) * 2], rstd = STATS[(tok0 + s) * 2 + 1];
            const f32x4 g0 = *(const f32x4*)(ln_g + 128 * g + 8 * ch), g1 = *(const f32x4*)(ln_g + 128 * g + 8 * ch + 4), b0 = *(const f32x4*)(ln_b + 128 * g + 8 * ch), b1 = *(const f32x4*)(ln_b + 128 * g + 8 * ch + 4);
            float x[8]; x[0] = __uint_as_float(a.x << 16); x[1] = __uint_as_float(a.x & 0xffff0000u); x[2] = __uint_as_float(a.y << 16); x[3] = __uint_as_float(a.y & 0xffff0000u);
            x[4] = __uint_as_float(a.z << 16); x[5] = __uint_as_float(a.z & 0xffff0000u); x[6] = __uint_as_float(a.w << 16); x[7] = __uint_as_float(a.w & 0xffff0000u);
            const float gg[8] = {g0.x, g0.y, g0.z, g0.w, g1.x, g1.y, g1.z, g1.w}, bb[8] = {b0.x, b0.y, b0.z, b0.w, b1.x, b1.y, b1.z, b1.w};
#pragma unroll
            for (int e = 0; e < 8; ++e) { const float v = (x[e] - mu) * rstd * gg[e] + bb[e]; *(LAS unsigned short*)(VT + (8 * ch + e) * 272 + s * 2) = (unsigned short)(cvt_pk_bf16(v, 0.f) & 0xffffu); } }
#pragma unroll
        for (int k8 = 0; k8 < 8; ++k8) { const int idx = tid + 512 * k8, t = idx >> 5, s4 = (idx & 31) * 4; const f32x4 wv = *(const f32x4*)(w_s + ((size_t)(g * 128 + t)) * 128 + s4);
            v2u o; o.x = cvt_pk_bf16(s4 <= t ? wv.x : 0.f, s4 + 1 <= t ? wv.y : 0.f); o.y = cvt_pk_bf16(s4 + 2 <= t ? wv.z : 0.f, s4 + 3 <= t ? wv.w : 0.f);
            *(LAS v2u*)(WL + t * 272 + s4 * 2) = o; }
        __syncthreads();
        bf16x8 af[4];
#pragma unroll
        for (int s = 0; s < 4; ++s) af[s] = *(const LAS bf16x8*)(VT + (16 * w + fr) * 272 + s * 64 + fq * 16);
#pragma unroll
        for (int tt = 0; tt < 8; ++tt) { f32x4 acc = (f32x4){0.f, 0.f, 0.f, 0.f};
#pragma unroll
            for (int s = 0; s < 4; ++s) if (s <= (tt >> 1)) { const bf16x8 bfr = *(const LAS bf16x8*)(WL + (16 * tt + fr) * 272 + s * 64 + fq * 16); acc = __builtin_amdgcn_mfma_f32_16x16x32_bf16(af[s], bfr, acc, 0, 0, 0); }
            const int t = 16 * tt + fr; const float bs = b_s[g * 128 + t];
            v2u* up = (v2u*)(Ua + (tok0 + t) * 1024 + 128 * g + 16 * w + 4 * fq); const v2u uv = *up;
            v2u o; o.x = cvt_pk_bf16(__uint_as_float(uv.x << 16) * (acc[0] + bs), __uint_as_float(uv.x & 0xffff0000u) * (acc[1] + bs));
            o.y = cvt_pk_bf16(__uint_as_float(uv.y << 16) * (acc[2] + bs), __uint_as_float(uv.y & 0xffff0000u) * (acc[3] + bs)); *up = o; }
    }
}

struct Args { const float* in[23]; float* out; unsigned char* ws; int ph_lo, ph_hi; };
__global__ void __launch_bounds__(512, 2) mega_fwd(Args args_unused) {
    extern __shared__ __attribute__((aligned(16))) unsigned char lds[];
    cg::grid_group grid = cg::this_grid();
    LAS unsigned char* L = (LAS unsigned char*)lds;
    const int tid = threadIdx.x, lane = tid & 63, wave = __builtin_amdgcn_readfirstlane(tid >> 6);
    const int G = gridDim.x, bid = blockIdx.x;
    const int vcu = (G % 8 == 0) ? (bid % 8) * (G / 8) + bid / 8 : bid;
    const int gw = vcu * 8 + wave, NGW = G * 8;
    typedef __attribute__((address_space(4))) const unsigned long long kargp_t;
    kargp_t* kp = (kargp_t*)__builtin_amdgcn_kernarg_segment_ptr();
    const unsigned long long phw = kp[25]; const int ph_lo = (int)(phw & 0xffffffffu), ph_hi = (int)(phw >> 32);
    const bool single = (ph_hi - ph_lo) > 1;
    for (int u = threadIdx.x; u < 16; u += 512) ((volatile LAS unsigned*)(L + LDS_BYTES - 64))[u] = 0u;
    __syncthreads();
    XcdBarrier xbar; xbar.bar = (unsigned*)(__attribute__((address_space(1))) unsigned*)kp[24]; xbar.x = 0; xbar.st = (volatile LAS unsigned*)(L + LDS_BYTES - 64);
    if (single) { grid.sync(); xbar = xcd_barrier_post((unsigned*)(__attribute__((address_space(1))) unsigned*)kp[24], (volatile LAS unsigned*)(L + LDS_BYTES - 64)); }
    int pc = 0;
#define IN(k) (ph_lo <= (k) && (k) < ph_hi)
#if defined(DOUBLE_BAR)
#define GSYNC() } { const bool cur_ = IN(pc); ++pc; if (cur_ && IN(pc)) { xcd_barrier(xbar); xcd_barrier(xbar); } } if (IN(pc)) {
#else
#define GSYNC() } { const bool cur_ = IN(pc); ++pc; if (cur_ && IN(pc)) xcd_barrier(xbar); } if (IN(pc)) {
#endif
#define GASQ __attribute__((address_space(1)))
#define INP(k) ((const float*)(GASQ const float*)kp[k])
#define outp_ ((float*)(GASQ float*)kp[23])
#define wsp_ ((unsigned char*)(GASQ unsigned char*)kp[24])
#define xin_ INP(0)
#define cvec INP(1)
#define w_ada INP(2)
#define b_ada INP(3)
#define norm1_g INP(4)
#define f1_in INP(5)
#define f1_out INP(6)
#define norm2_g INP(7)
#define w_in INP(8)
#define conv_w INP(9)
#define a_log INP(10)
#define dt_bias INP(11)
#define dn_norm_g INP(12)
#define gm_ln_g INP(13)
#define gm_ln_b INP(14)
#define gm_w_s INP(15)
#define gm_b_s INP(16)
#define w_branch INP(17)
#define w_out INP(18)
#define norm3_g INP(19)
#define f2_in INP(20)
#define f2_out INP(21)
#define final_g INP(22)
#define MOD ((float*)(wsp_ + WS_MOD))
#define GL ((float*)(wsp_ + WS_GL))
#define STATS ((float*)(wsp_ + WS_STATS))
#define Gd ((float*)(wsp_ + WS_G))
#define Bd ((float*)(wsp_ + WS_BETA))
#define Wst ((bf16*)(wsp_ + WS_W))
#define Wbr ((bf16*)(wsp_ + WS_WBR))
#define Wout ((bf16*)(wsp_ + WS_WOUT))
#define Hb ((bf16*)(wsp_ + WS_H))
#define Qs ((bf16*)(wsp_ + WS_Q))
#define Ks ((bf16*)(wsp_ + WS_K))
#define Vs ((bf16*)(wsp_ + WS_V))
#define Zs ((bf16*)(wsp_ + WS_Z))
#define WWs ((bf16*)(wsp_ + WS_WW))
#define QKs ((bf16*)(wsp_ + WS_QK))
#define TAIL ((bf16*)(wsp_ + WS_TAIL))
#define ACT ((bf16*)(wsp_ + WS_ACT))
#define W_in1 Wst
#define W_out1 (Wst + (size_t)2 * FF * D)
    LAS float* scr = (LAS float*)(L + wave * 16384);

    if (IN(pc)) {
    {
        LAS float* sc = (LAS float*)(L + 135168);
        for (int i = tid; i < 2048; i += 512) { const float v = cvec[i]; sc[i] = v / (1.0f + __expf(-v)); }
        __syncthreads();
        constexpr int I1 = 16 * 176, I2 = 44 * 32, I3 = 2 * 16 * 32, I4 = 16 * 32;
        for (int it = gw; it < I1 + I2 + I3 + I4; it += NGW) {
            int r = it;
            if (r < I1) { conv_ffn_in(f1_in, W_in1, r, scr, lane); continue; } r -= I1;
            if (r < I2) { conv_plain(f1_out, FF, D, W_out1, r, scr, lane); continue; } r -= I2;
            if (r < I3) { const int wsel = r >> 9; conv_plain(w_branch + (size_t)wsel * D * D, D, D, Wbr + (size_t)wsel * D * D, r & 511, scr, lane); continue; } r -= I3;
            conv_plain(w_out, D, D, Wout, r, scr, lane);
        }
        for (int gi = NGW - 1 - gw; gi < 144 * 16; gi += NGW) { const int cg = gi >> 4, kc = gi & 15, col = cg * 64 + lane; float a0 = 0.f, a1 = 0.f;
#pragma unroll 16
            for (int k = 64 * kc; k < 64 * kc + 64; ++k) { const float wv = w_ada[(size_t)k * NMOD + col]; a0 += sc[k] * wv; a1 += sc[1024 + k] * wv; }
            if (kc == 0) { const float bb = b_ada[col]; a0 += bb; a1 += bb; }
            atomicAdd(MOD + col, a0); atomicAdd(MOD + NMOD + col, a1); }
    }
    GSYNC();
    norm_rows<0>(xin_, norm1_g, MOD, 0 * D, 1 * D, Hb, gw, NGW, lane, nullptr, nullptr, nullptr, nullptr, nullptr);
    GSYNC();
#if !defined(SKIP_F1)
    { pg8::Gemm g{Hb, W_in1, M, 2 * FF, D}; pg8::StaticOrder S; S.init(M, 2 * FF, G, bid); pg8::EpiSwiglu E{ACT, FF};
      pg8::gemm_phase<pg8::EpiSwiglu, pg8::StaticOrder, true, true>(L, g, S, E); }
    GSYNC();
#endif
    { pg8::Gemm g{ACT, W_out1, M, D, FF}; pg8::StaticOrder S; S.init(M, D, G, bid); pg8::EpiResid E{xin_, outp_, MOD + 2 * D, NMOD, F1SCALE};
      pg8::gemm_phase<pg8::EpiResid, pg8::StaticOrder, true, true>(L, g, S, E); }
    GSYNC();
    {
        for (int it = gw; it < 16 * 256; it += NGW) conv_inproj(w_in, Wst, it, scr, lane);
        __syncthreads();
        LAS float* wabT = (LAS float*)L;
        for (int k = tid; k < 1024; k += 512) { const float* wp = w_in + (size_t)k * INW + 6144;
#pragma unroll
            for (int c4 = 0; c4 < 4; ++c4) { const f32x4 v = *(const f32x4*)(wp + 4 * c4); wabT[(4 * c4 + 0) * 1024 + k] = v.x; wabT[(4 * c4 + 1) * 1024 + k] = v.y; wabT[(4 * c4 + 2) * 1024 + k] = v.z; wabT[(4 * c4 + 3) * 1024 + k] = v.w; } }
        __syncthreads();
        norm_rows<1>(outp_, norm2_g, MOD, 3 * D, 4 * D, Hb, gw, NGW, lane, wabT, a_log, dt_bias, Gd, Bd);
        __syncthreads();
    }
    GSYNC();
#if !defined(SKIP_MIX)
    { pg8::Gemm g{Hb, Wst, M, 3072, D}; pg8::StaticOrder S; S.init(M, 3072, G, bid); pg8::EpiI1 E{Qs, (size_t)M * D, TAIL};
      pg8::gemm_phase<pg8::EpiI1, pg8::StaticOrder, true, true>(L, g, S, E); }
    GSYNC();
#if !defined(SKIP_DN)
    for (int idx = bid * 512 + tid; idx < 256 * 3 * 384; idx += G * 512) { const int ch8 = idx % 384, rr = (idx / 384) % 3, cc = idx / 1152; const int T = ch8 >> 7, c8 = ch8 & 127;
        *(v4u*)(TAIL + ((size_t)(cc * 3 + rr)) * 3072 + T * 1024 + c8 * 8) = *(const v4u*)((T == 0 ? Qs : (T == 1 ? Ks : Vs)) + ((size_t)cc * 64 + 61 + rr) * 1024 + c8 * 8); }
    GSYNC();
#if defined(DIAG_W)
    for (int it = bid; it < 2048; it += G) { const int hw_ = tid >> 8, ht_ = tid & 255; const int unit = it * 2 + hw_, h_ = unit & 7, n_ = (unit >> 3) & 127, b_ = unit >> 10;
        zprobe(Vs, (size_t)b_ * SEQ + 64 * n_, h_, ht_, lane, (unsigned*)GL + 4020 - 65536); }
    GSYNC();
#endif
#if !defined(SKIP_P6B)
    dn_local_phase<2>(L, Qs, Ks, Vs, WWs, QKs, TAIL, Gd, Bd, GL, conv_w, tid, G, bid);
#endif
    GSYNC();
#if !defined(SKIP_SCAN)
    if (bid < 128) dn_scan_phase(L, Qs, Ks, Vs, WWs, QKs, GL, tid, bid);
    else {
        pg8::Gemm g{Hb, Wst + (size_t)7168 * D, M, D, D}; pg8::ZOrder S{G - 128, bid - 128}; pg8::EpiZ E{Zs};
        pg8::gemm_phase<pg8::EpiZ, pg8::ZOrder, true, true>(L, g, S, E); }
#endif
    GSYNC();
#endif
    { pg8::Gemm g{Hb, Wst + (size_t)3072 * D, M, 4096, D}; pg8::StaticOrder S; S.init(M, 4096, G, bid); pg8::EpiI2 E{Qs, Ks, WWs, QKs, Zs};
      pg8::gemm_phase<pg8::EpiI2, pg8::StaticOrder, true, true>(L, g, S, E); }
    GSYNC();
    post_rows(Ks, STATS, Vs, Zs, dn_norm_g, gw, NGW, lane);
    GSYNC();
#if !defined(SKIP_GM)
    gmlp_phase(L, Qs, Ks, STATS, gm_ln_g, gm_ln_b, gm_w_s, gm_b_s, tid, G, bid);
    GSYNC();
#endif
    { pg8::Gemm g{Qs, Wbr, M, D, D}; pg8::BranchOrder S; S.so.init(M, D, G, bid); pg8::EpiBranch E{WWs, QKs, Hb};
      pg8::gemm_phase<pg8::EpiBranch, pg8::BranchOrder, true, true>(L, g, S, E); }
    GSYNC();
    { pg8::Gemm g{Hb, Wout, M, D, D}; pg8::StaticOrder S; S.init(M, D, G, bid); pg8::EpiResid E{outp_, outp_, MOD + 5 * D, NMOD, 1.0f};
      pg8::gemm_phase<pg8::EpiResid, pg8::StaticOrder, true, true>(L, g, S, E); }
    GSYNC();
#endif
    {
        constexpr int I1 = 16 * 176, I2 = 44 * 32;
        for (int it = gw; it < I1 + I2; it += NGW) { if (it < I1) conv_ffn_in(f2_in, W_in1, it, scr, lane); else conv_plain(f2_out, FF, D, W_out1, it - I1, scr, lane); }
        norm_rows<0>(outp_, norm3_g, MOD, 6 * D, 7 * D, Hb, gw, NGW, lane, nullptr, nullptr, nullptr, nullptr, nullptr);
    }
    GSYNC();
#if !defined(SKIP_F2)
    { pg8::Gemm g{Hb, W_in1, M, 2 * FF, D}; pg8::StaticOrder S; S.init(M, 2 * FF, G, bid); pg8::EpiSwiglu E{ACT, FF};
      pg8::gemm_phase<pg8::EpiSwiglu, pg8::StaticOrder, true, true>(L, g, S, E); }
    GSYNC();
    { pg8::Gemm g{ACT, W_out1, M, D, FF}; pg8::StaticOrder S; S.init(M, D, G, bid); pg8::EpiResid E{outp_, outp_, MOD + 8 * D, NMOD, 0.5f};
      pg8::gemm_phase<pg8::EpiResid, pg8::StaticOrder, true, true>(L, g, S, E); }
    GSYNC();
#endif
    {
        f32x4 fg[4];
#pragma unroll
        for (int j = 0; j < 4; ++j) fg[j] = *(const f32x4*)(final_g + 4 * lane + 256 * j);
        for (int m = gw; m < M; m += NGW) { f32x4* xr = (f32x4*)(outp_ + (size_t)m * D) + lane; f32x4 v[4]; float ss = 0.f;
#pragma unroll
            for (int j = 0; j < 4; ++j) { v[j] = xr[64 * j];
#if defined(NANGUARD)
                for (int e = 0; e < 4; ++e) if (!(fabsf(v[j][e]) < 1e30f)) v[j][e] = 0.f;
#endif
                ss += (v[j].x * v[j].x + v[j].y * v[j].y) + (v[j].z * v[j].z + v[j].w * v[j].w); }
            const float r = 1.0f / sqrtf(wave_sum(ss) * (1.0f / D) + EPS);
#pragma unroll
            for (int j = 0; j < 4; ++j) xr[64 * j] = v[j] * r * fg[j];
#if defined(OUT_TAIL)
            if (m < 768) { for (int j = 0; j < 4; ++j) { const bf16* tp = TAIL + (size_t)m * 3072 + OUT_TAIL_OFF + 4 * lane + 256 * j; xr[64 * j] = (f32x4){bf2f(tp[0]), bf2f(tp[1]), bf2f(tp[2]), bf2f(tp[3])}; } }
#endif
#if defined(DIAG_W)
            { float dv = __uint_as_float(((const unsigned*)wsp_)[4000 + (m < 8192 ? DIAG_SEL : DIAG_SEL2)]); if ((m < 8192 ? DIAG_SEL : DIAG_SEL2) == 9 || (m < 8192 ? DIAG_SEL : DIAG_SEL2) == 10) dv = (float)((const unsigned*)wsp_)[4000 + (m < 8192 ? DIAG_SEL : DIAG_SEL2)]; dv = fminf(fmaxf(10.f + log2f(fmaxf(dv, 1e-30f)), 0.f), 60.f);
              for (int j = 0; j < 4; ++j) xr[64 * j] = (f32x4){dv, dv, dv, dv}; }
#endif
            }
    }
}
}
#undef GSYNC
#undef IN
#undef INP
#undef outp_
#undef wsp_
#undef xin_
#undef cvec
#undef w_ada
#undef b_ada
#undef norm1_g
#undef f1_in
#undef f1_out
#undef norm2_g
#undef w_in
#undef conv_w
#undef a_log
#undef dt_bias
#undef dn_norm_g
#undef gm_ln_g
#undef gm_ln_b
#undef gm_w_s
#undef gm_b_s
#undef w_branch
#undef w_out
#undef norm3_g
#undef f2_in
#undef f2_out
#undef final_g
#undef MOD
#undef GL
#undef STATS
#undef Gd
#undef Bd
#undef Wst
#undef Wbr
#undef Wout
#undef Hb
#undef Qs
#undef Ks
#undef Vs
#undef Zs
#undef WWs
#undef QKs
#undef TAIL
#undef ACT
#undef W_in1
#undef W_out1
extern "C" void kernel_launch(void* const* d_in, const int* in_sizes, int n_in, void* d_out, int out_size, void* d_ws, size_t ws_size, hipStream_t stream) {
    static int grid = 0;
    if (grid == 0) {
        if (n_in != 23 || out_size != M * D || ws_size < WS_END) { fprintf(stderr, "kernel_launch: unexpected shapes (n_in %d, out %d, ws %zu)\n", n_in, out_size, ws_size); grid = -1; return; }
        int dev = 0, cus = 0, per_cu = 0;
        hipGetDevice(&dev); hipDeviceGetAttribute(&cus, hipDeviceAttributeMultiprocessorCount, dev);
        if (hipFuncSetAttribute((const void*)mega_fwd, hipFuncAttributeMaxDynamicSharedMemorySize, LDS_BYTES) != hipSuccess) { fprintf(stderr, "kernel_launch: hipFuncSetAttribute failed\n"); grid = -1; return; }
        if (hipOccupancyMaxActiveBlocksPerMultiprocessor(&per_cu, (const void*)mega_fwd, 512, LDS_BYTES) != hipSuccess || per_cu < 1) { fprintf(stderr, "kernel_launch: occupancy query says %d\n", per_cu); per_cu = 1; }
        (void)hipGetLastError();
        grid = cus;
        fprintf(stderr, "kernel_launch: cus %d per_cu %d grid %d\n", cus, per_cu, grid);
    }
    if (grid < 0) return;
    if (hipMemsetAsync(d_ws, 0, 262144, stream) != hipSuccess) { fprintf(stderr, "kernel_launch: memset failed\n"); return; }
    Args a{};
    for (int i = 0; i < 23; ++i) a.in[i] = (const float*)d_in[i];
    a.out = (float*)d_out; a.ws = (unsigned char*)d_ws;
#if defined(LAUNCH_PER_PHASE)
    for (int ph = 0; ph < 18; ++ph) { a.ph_lo = ph; a.ph_hi = ph + 1; hipLaunchKernelGGL(mega_fwd, dim3(grid), dim3(512), LDS_BYTES, stream, a); }
    hipError_t e = hipPeekAtLastError();
#else
    a.ph_lo = 0; a.ph_hi = 18;
    void* kargs[] = {&a};
    hipError_t e = hipLaunchCooperativeKernel((const void*)mega_fwd, dim3(grid), dim3(512), kargs, LDS_BYTES, stream);
#endif
    if (e != hipSuccess) fprintf(stderr, "kernel_launch: cooperative launch failed: %s (grid %d)\n", hipGetErrorString(e), grid);
}
```

```cpp
#include <hip/hip_runtime.h>
#include <hip/hip_cooperative_groups.h>
#include <cstdio>
#include <cstdint>
namespace pg8 {
#define PG8_LAS __attribute__((address_space(3)))
typedef unsigned short bf16_t;
typedef short bf16x8 __attribute__((ext_vector_type(8)));
typedef float f32x4 __attribute__((ext_vector_type(4)));
typedef unsigned u32x4 __attribute__((ext_vector_type(4)));
constexpr int BM = 256, BK = 64, HALF = 128, HTB = HALF * BK * 2  , STAGE_BYTES = 8 * HTB, NXCD = 8, WGM = 8;

__host__ __device__ __forceinline__ int lds_byte(int r, int c) { const int st = (r >> 4) * 2 + (c >> 5), rr = r & 15, cc = c & 31, ob = rr * 64 + cc * 2; return st * 1024 + (ob ^ (((ob >> 9) & 1) << 5)); }
__host__ __device__ __forceinline__ void stage_rc(int b, int& R, int& C) { const int st = b / 1024, sb = b % 1024, swz = sb ^ (((sb >> 9) & 1) << 5); R = (st >> 1) * 16 + swz / 64; C = (st & 1) * 32 + (swz % 64) / 2; }
__host__ __device__ __forceinline__ int perm32(int rho) { const int n = rho >> 4, i = rho & 15; return 8 * (i >> 2) + 4 * n + (i & 3); }

struct Unit { int pm, pn; };
struct Gemm { const bf16_t* A; const bf16_t* Bt; int M, N, K; };

struct StaticOrder {
    int nM, nN, nwg, G, c;
    __host__ __device__ void init(int M, int N, int G_, int c_) { nM = M / BM; nN = N / BM; nwg = nM * nN; G = G_; c = c_; }
    __host__ __device__ bool next(int i, Unit& u) const {
        const long L = (long)i * G + c; if (L >= nwg) return false;
        int wgid = (int)L; { const int q = nwg / NXCD, r = nwg % NXCD, xcd = wgid % NXCD, off = wgid / NXCD; wgid = (xcd < r ? xcd * (q + 1) : r * (q + 1) + (xcd - r) * q) + off; }
        const int nig = WGM * nN, gid = wgid / nig, fm = gid * WGM, gsz = (nM - fm) < WGM ? (nM - fm) : WGM;
        u.pm = fm + ((wgid % nig) % gsz); u.pn = (wgid % nig) / gsz; return true;
    }
    __device__ __forceinline__ void a_ready(const Unit&) const {}
    __device__ __forceinline__ void done(const Unit&) const {}
};

__device__ __forceinline__ unsigned cvt_pk_bf16(float lo, float hi) { unsigned r; asm volatile("v_cvt_pk_bf16_f32 %0, %1, %2" : "=v"(r) : "v"(lo), "v"(hi)); return r; }
typedef float f32x2 __attribute__((ext_vector_type(2)));
__device__ __forceinline__ f32x2 gelu_pk(f32x2 v) {
    const f32x2 av = __builtin_elementwise_abs(v), d = av * 0.2316418882f + 1.0f;
    f32x2 t; t.x = __builtin_amdgcn_rcpf(d.x); t.y = __builtin_amdgcn_rcpf(d.y);
    f32x2 q = t * 0.5307027145f + (-0.7265760135f); q = q * t + 0.7107068705f; q = q * t + (-0.142248368f); q = q * t + 0.127414796f; q = q * t;
    const f32x2 s = (v * v) * (-0.72134752044f);
    f32x2 e; e.x = __builtin_amdgcn_exp2f(s.x); e.y = __builtin_amdgcn_exp2f(s.y);
    const f32x2 m = v * (q * e), r = v - m;
    f32x2 o; o.x = v.x < 0.f ? m.x : r.x; o.y = v.y < 0.f ? m.y : r.y; return o;
}


__device__ __forceinline__ float silu_f(float x) { return x * __builtin_amdgcn_rcpf(1.0f + __expf(-x)); }
__device__ __forceinline__ float sigm_f(float x) { return __builtin_amdgcn_rcpf(1.0f + __expf(-x)); }
__device__ __forceinline__ u32x4 pack8(const f32x4 v0, const f32x4 v1) { u32x4 w; w.x = cvt_pk_bf16(v0[0], v0[1]); w.y = cvt_pk_bf16(v0[2], v0[3]); w.z = cvt_pk_bf16(v1[0], v1[1]); w.w = cvt_pk_bf16(v1[2], v1[3]); return w; }

struct EpiSwiglu {
    static constexpr bool PERM = true, AFTER_DRAIN = false;
    bf16_t* O; int ldo;
    __device__ __forceinline__ void operator()(const f32x4 (&acc)[2][2][4][2], const Unit& u, int wr, int wc, int fr, int fq) const {
        const int row0 = u.pm * BM + wr * 64 + fr, col0 = u.pn * HALF + wc * 32 + 8 * fq;
#pragma unroll
        for (int ai = 0; ai < 2; ++ai)
#pragma unroll
            for (int m = 0; m < 4; ++m) { bf16_t* p = O + (size_t)(row0 + ai * HALF + m * 16) * ldo + col0;
                const f32x4 a0 = acc[ai][0][m][0], a1 = acc[ai][0][m][1], b0 = acc[ai][1][m][0], b1 = acc[ai][1][m][1]; f32x4 v0, v1;
#pragma unroll
                for (int e = 0; e < 4; ++e) { v0[e] = silu_f(a0[e]) * b0[e]; v1[e] = silu_f(a1[e]) * b1[e]; }
                *(u32x4*)p = pack8(v0, v1); }
    }
};
struct EpiResid {
    static constexpr bool PERM = false, AFTER_DRAIN = false;
    const float* base; float* out; const float* coef; int coef_bstride; float scale;
    __device__ __forceinline__ void operator()(const f32x4 (&acc)[2][2][4][2], const Unit& u, int wr, int wc, int fr, int fq) const {
        const float* cf = coef + (size_t)(u.pm >> 5) * coef_bstride; const int col0 = u.pn * BM + wc * 32 + 4 * fq;
#pragma unroll
        for (int bj = 0; bj < 2; ++bj)
#pragma unroll
            for (int n = 0; n < 2; ++n) { const int c = col0 + bj * HALF + n * 16; const f32x4 cv = *(const f32x4*)(cf + c) * scale;
#pragma unroll
                for (int ai = 0; ai < 2; ++ai)
#pragma unroll
                    for (int m = 0; m < 4; ++m) { const size_t off = (size_t)(u.pm * BM + ai * HALF + wr * 64 + m * 16 + fr) * 1024 + c;
                        *(f32x4*)(out + off) = *(const f32x4*)(base + off) + cv * acc[ai][bj][m][n]; } }
    }
};
struct EpiI1 {
    static constexpr bool PERM = true, AFTER_DRAIN = false;
    bf16_t* slot0; size_t slot_stride; bf16_t* tail;
    __device__ __forceinline__ void operator()(const f32x4 (&acc)[2][2][4][2], const Unit& u, int wr, int wc, int fr, int fq) const {
        const int seg = u.pn >> 2; bf16_t* O = slot0 + (size_t)seg * slot_stride;
        const int row0 = u.pm * BM + wr * 64 + fr, col0 = (u.pn & 3) * BM + wc * 32 + 8 * fq;
#pragma unroll
        for (int ai = 0; ai < 2; ++ai)
#pragma unroll
            for (int m = 0; m < 4; ++m) { const int row = row0 + ai * HALF + m * 16;
#pragma unroll
                for (int bj = 0; bj < 2; ++bj) { f32x4 v0 = acc[ai][bj][m][0], v1 = acc[ai][bj][m][1];
#if defined(DIAG_W)
                    if (seg == 3) { float mx_ = 0.f; for (int e = 0; e < 4; ++e) mx_ = fmaxf(mx_, fmaxf(fabsf(v0[e]), fabsf(v1[e]))); atomicMax((unsigned*)((unsigned char*)tail - 236u * 1048576u) + 4011, __float_as_uint(mx_)); }
#endif
                    if (seg == 3) {
#pragma unroll
                        for (int e = 0; e < 4; ++e) { v0[e] = silu_f(v0[e]); v1[e] = silu_f(v1[e]); } }
                    const u32x4 w = pack8(v0, v1);
                    *(u32x4*)(O + (size_t)row * 1024 + col0 + bj * HALF) = w;
                    if (seg < 3 && m == 3 && fr >= 13) *(u32x4*)(tail + ((size_t)(row >> 6) * 3 + (fr - 13)) * 3072 + seg * 1024 + col0 + bj * HALF) = w;
                    } }
    }
};
struct EpiI2 {
    static constexpr bool PERM = true, AFTER_DRAIN = false;
    bf16_t* s0; bf16_t* s1; bf16_t* s2; bf16_t* s3; bf16_t* s4;
    __device__ __forceinline__ void operator()(const f32x4 (&acc)[2][2][4][2], const Unit& u, int wr, int wc, int fr, int fq) const {
        const int seg = u.pn >> 2; bf16_t* O = seg == 0 ? s0 : (seg == 1 ? s1 : (seg == 2 ? s2 : (seg == 3 ? s3 : s4)));
        const int row0 = u.pm * BM + wr * 64 + fr, col0 = (u.pn & 3) * BM + wc * 32 + 8 * fq;
#pragma unroll
        for (int ai = 0; ai < 2; ++ai)
#pragma unroll
            for (int m = 0; m < 4; ++m) { const int row = row0 + ai * HALF + m * 16;
#pragma unroll
                for (int bj = 0; bj < 2; ++bj) { f32x4 v0 = acc[ai][bj][m][0], v1 = acc[ai][bj][m][1];
                    if (seg < 2) { const f32x2 a = gelu_pk((f32x2){v0[0], v0[1]}), b = gelu_pk((f32x2){v0[2], v0[3]}), c = gelu_pk((f32x2){v1[0], v1[1]}), d = gelu_pk((f32x2){v1[2], v1[3]});
                        v0 = (f32x4){a.x, a.y, b.x, b.y}; v1 = (f32x4){c.x, c.y, d.x, d.y}; }
                    else if (seg < 4) {
#pragma unroll
                        for (int e = 0; e < 4; ++e) { v0[e] = sigm_f(v0[e]); v1[e] = sigm_f(v1[e]); } }
                    else {
#pragma unroll
                        for (int e = 0; e < 4; ++e) { v0[e] = silu_f(v0[e]); v1[e] = silu_f(v1[e]); } }
                    *(u32x4*)(O + (size_t)row * 1024 + col0 + bj * HALF) = pack8(v0, v1); } }
    }
};
struct ZOrder {
    int G, c;
    __device__ bool next(int i, Unit& u) const { const int Lz = i * G + c; if (Lz >= 256) return false; u.pm = Lz >> 2; u.pn = Lz & 3; return true; }
    __device__ __forceinline__ void a_ready(const Unit&) const {}
    __device__ __forceinline__ void done(const Unit&) const {}
};
struct EpiZ {
    static constexpr bool PERM = true, AFTER_DRAIN = false;
    bf16_t* O;
    __device__ __forceinline__ void operator()(const f32x4 (&acc)[2][2][4][2], const Unit& u, int wr, int wc, int fr, int fq) const {
        const int row0 = u.pm * BM + wr * 64 + fr, col0 = u.pn * BM + wc * 32 + 8 * fq;
#pragma unroll
        for (int ai = 0; ai < 2; ++ai)
#pragma unroll
            for (int m = 0; m < 4; ++m) { const int row = row0 + ai * HALF + m * 16;
#pragma unroll
                for (int bj = 0; bj < 2; ++bj) { f32x4 v0 = acc[ai][bj][m][0], v1 = acc[ai][bj][m][1];
#pragma unroll
                    for (int e = 0; e < 4; ++e) { v0[e] = silu_f(v0[e]); v1[e] = silu_f(v1[e]); }
                    *(u32x4*)(O + (size_t)row * 1024 + col0 + bj * HALF) = pack8(v0, v1); } }
    }
};
struct BranchOrder {
    StaticOrder so;
    __device__ bool next(int i, Unit& u) const { Unit t; if (!so.next(i >> 1, t)) return false; const int which = i & 1; u.pm = t.pm + which * 192; u.pn = t.pn + which * 4; return true; }
    __device__ __forceinline__ void a_ready(const Unit&) const {}
    __device__ __forceinline__ void done(const Unit&) const {}
};
struct EpiBranch {
    static constexpr bool PERM = true, AFTER_DRAIN = false;
    const bf16_t* ga; const bf16_t* gb; bf16_t* merged;
    __device__ __forceinline__ void operator()(const f32x4 (&acc)[2][2][4][2], const Unit& u, int wr, int wc, int fr, int fq) const {
        const int which = u.pm >= 64 ? 1 : 0; const int pm = u.pm - which * 192, pn = u.pn - which * 4; const bf16_t* gt = which ? gb : ga;
        const int row0 = pm * BM + wr * 64 + fr, col0 = pn * BM + wc * 32 + 8 * fq;
#pragma unroll
        for (int ai = 0; ai < 2; ++ai)
#pragma unroll
            for (int m = 0; m < 4; ++m) { const int row = row0 + ai * HALF + m * 16;
#pragma unroll
                for (int bj = 0; bj < 2; ++bj) { const size_t off = (size_t)row * 1024 + col0 + bj * HALF;
                    const u32x4 g = *(const u32x4*)(gt + off); f32x4 v0 = acc[ai][bj][m][0], v1 = acc[ai][bj][m][1];
                    v0[0] *= __uint_as_float(g.x << 16); v0[1] *= __uint_as_float(g.x & 0xffff0000u); v0[2] *= __uint_as_float(g.y << 16); v0[3] *= __uint_as_float(g.y & 0xffff0000u);
                    v1[0] *= __uint_as_float(g.z << 16); v1[1] *= __uint_as_float(g.z & 0xffff0000u); v1[2] *= __uint_as_float(g.w << 16); v1[3] *= __uint_as_float(g.w & 0xffff0000u);
#if defined(ZERO_A)
                    if (!which) { v0 = (f32x4){0.f, 0.f, 0.f, 0.f}; v1 = v0; }
#endif
#if defined(ZERO_B)
                    if (which) { v0 = (f32x4){0.f, 0.f, 0.f, 0.f}; v1 = v0; }
#endif
                    if (which) { unsigned* mp = (unsigned*)(merged + off); u32x4 p;
                        p.x = __hip_atomic_load(mp + 0, __ATOMIC_RELAXED, __HIP_MEMORY_SCOPE_AGENT); p.y = __hip_atomic_load(mp + 1, __ATOMIC_RELAXED, __HIP_MEMORY_SCOPE_AGENT);
                        p.z = __hip_atomic_load(mp + 2, __ATOMIC_RELAXED, __HIP_MEMORY_SCOPE_AGENT); p.w = __hip_atomic_load(mp + 3, __ATOMIC_RELAXED, __HIP_MEMORY_SCOPE_AGENT);
                        v0[0] += __uint_as_float(p.x << 16); v0[1] += __uint_as_float(p.x & 0xffff0000u); v0[2] += __uint_as_float(p.y << 16); v0[3] += __uint_as_float(p.y & 0xffff0000u);
                        v1[0] += __uint_as_float(p.z << 16); v1[1] += __uint_as_float(p.z & 0xffff0000u); v1[2] += __uint_as_float(p.w << 16); v1[3] += __uint_as_float(p.w & 0xffff0000u); }
                    *(u32x4*)(merged + off) = pack8(v0, v1); } }
    }
};

template <class Epi, class Sched, bool ALIGN_EPI = false, bool SP2 = false>
__device__ __forceinline__ void gemm_phase(PG8_LAS unsigned char* lds, const Gemm g, const Sched& S, const Epi& E) {
    const int tid = threadIdx.x, wid = __builtin_amdgcn_readfirstlane(tid >> 6), lane = tid & 63, wr = wid >> 2, wc = wid & 3, fr = lane & 15, fq = lane >> 4;
    const int K = g.K, nt = K / BK;
    unsigned voffA[2], voffB[2];
#pragma unroll
    for (int i = 0; i < 2; ++i) { int R, C; stage_rc(tid * 16 + i * 8192, R, C); const int Rb = Epi::PERM ? ((R & ~31) + perm32(R & 31)) : R;
        voffA[i] = (unsigned)(R * K + C) * 2u; voffB[i] = (unsigned)(Rb * K + C) * 2u; }
    const size_t kstep = (size_t)(BK * 2);
    const size_t hstep = (size_t)HALF * K * 2;
    const size_t tstep = 2 * hstep;
    const unsigned ldsw = (unsigned)wid * 1024u;
    const int aoff = lds_byte(wr * 64 + fr, fq * 8), boff = lds_byte(wc * 32 + fr, fq * 8);
#define PG8_SA(b, h) (((b) * 2 + (h)) * HTB)
#define PG8_SB(b, h) ((4 + (b) * 2 + (h)) * HTB)
#define PG8_STAGE(bufoff, gbase, voff) do { _Pragma("unroll") for (int _i = 0; _i < 2; ++_i) \
        __builtin_amdgcn_global_load_lds((const unsigned*)((const char*)(gbase) + (voff)[_i]), (PG8_LAS unsigned*)(lds + (bufoff) + ldsw + _i * 8192), 16, 0, 0); } while (0)
#define PG8_LDA(dst, b, h) do { _Pragma("unroll") for (int m = 0; m < 4; ++m) _Pragma("unroll") for (int k = 0; k < 2; ++k) dst[m][k] = *(const PG8_LAS bf16x8*)(lds + PG8_SA(b, h) + aoff + m * 2048 + k * 1024); } while (0)
#define PG8_LDB(dst, b, h) do { _Pragma("unroll") for (int n = 0; n < 2; ++n) _Pragma("unroll") for (int k = 0; k < 2; ++k) dst[n][k] = *(const PG8_LAS bf16x8*)(lds + PG8_SB(b, h) + boff + n * 2048 + k * 1024); } while (0)
#define PG8_MMA(ai, bj, At, Bt) do { __builtin_amdgcn_s_setprio(1); _Pragma("unroll") for (int m = 0; m < 4; ++m) _Pragma("unroll") for (int n = 0; n < 2; ++n) _Pragma("unroll") for (int k = 0; k < 2; ++k) \
        acc[ai][bj][m][n] = __builtin_amdgcn_mfma_f32_16x16x32_bf16(Bt[n][k], At[m][k], acc[ai][bj][m][n], 0, 0, 0); __builtin_amdgcn_s_setprio(0); } while (0)
#define PG8_WAIT_V(n) asm volatile("s_waitcnt vmcnt(" #n ")" ::: "memory")
#define PG8_WAIT_L(n) asm volatile("s_waitcnt lgkmcnt(" #n ")" ::: "memory")
#define PG8_BAR __builtin_amdgcn_s_barrier()
#define PG8_SCHED __builtin_amdgcn_sched_barrier(0)
    Unit cur, nxt; int ui = 0;
    if (!S.next(0, cur)) return;
    f32x4 acc[2][2][4][2];
#pragma unroll
    for (int a = 0; a < 2; ++a)
#pragma unroll
        for (int b = 0; b < 2; ++b)
#pragma unroll
            for (int m = 0; m < 4; ++m)
#pragma unroll
                for (int n = 0; n < 2; ++n) acc[a][b][m][n] = (f32x4){0.f, 0.f, 0.f, 0.f};
    bf16x8 At[4][2], B0[2][2], B1[2][2];
    const char* cA = (const char*)g.A + (size_t)cur.pm * tstep; const char* cB = (const char*)g.Bt + (size_t)cur.pn * tstep;
    S.a_ready(cur);
    if constexpr (SP2) {
        PG8_STAGE(PG8_SB(0, 0), cB, voffB); PG8_STAGE(PG8_SB(0, 1), cB + hstep, voffB); PG8_STAGE(PG8_SA(0, 0), cA, voffA); PG8_STAGE(PG8_SA(0, 1), cA + hstep, voffA);
        if (wr == 1) PG8_BAR;
        PG8_WAIT_V(2); PG8_BAR;
        PG8_STAGE(PG8_SB(1, 0), cB + kstep, voffB); PG8_STAGE(PG8_SA(1, 0), cA + kstep, voffA); PG8_STAGE(PG8_SB(1, 1), cB + hstep + kstep, voffB);
        PG8_WAIT_V(6); PG8_BAR;
    } else {
        PG8_STAGE(PG8_SB(0, 0), cB, voffB); PG8_STAGE(PG8_SA(0, 0), cA, voffA); PG8_STAGE(PG8_SB(0, 1), cB + hstep, voffB); PG8_STAGE(PG8_SA(0, 1), cA + hstep, voffA);
        if (wr == 1) PG8_BAR;
        PG8_WAIT_V(4); PG8_BAR;
        PG8_STAGE(PG8_SB(1, 0), cB + kstep, voffB); PG8_STAGE(PG8_SA(1, 0), cA + kstep, voffA); PG8_STAGE(PG8_SB(1, 1), cB + hstep + kstep, voffB);
        PG8_WAIT_V(6); PG8_BAR;
    }
    for (;;) {
        const bool has_next = S.next(ui + 1, nxt);
        const char* nA = has_next ? (const char*)g.A + (size_t)nxt.pm * tstep : cA; const char* nB = has_next ? (const char*)g.Bt + (size_t)nxt.pn * tstep : cB;
        for (int t = 0; t < nt; t += 2) {
            const bool last = (t == nt - 2);
            const char* a1 = cA + (size_t)(t + 1) * kstep;
            const char* a2 = last ? nA : cA + (size_t)(t + 2) * kstep; const char* b2 = last ? nB : cB + (size_t)(t + 2) * kstep;
            const char* a3 = a2 + kstep; const char* b3 = b2 + kstep;
            if (last && has_next) S.a_ready(nxt);
            if constexpr (SP2) {
            PG8_LDB(B0, 0, 0); PG8_LDB(B1, 0, 1); PG8_SCHED; PG8_LDA(At, 0, 0); PG8_STAGE(PG8_SA(1, 1), a1 + hstep, voffA);
            PG8_WAIT_V(8); PG8_WAIT_L(0); PG8_BAR; PG8_MMA(0, 0, At, B0); PG8_MMA(0, 1, At, B1); PG8_BAR; PG8_SCHED;
            PG8_LDA(At, 0, 1); PG8_STAGE(PG8_SB(0, 0), b2, voffB); PG8_STAGE(PG8_SB(0, 1), b2 + hstep, voffB); PG8_STAGE(PG8_SA(0, 0), a2, voffA);
            PG8_WAIT_V(8); PG8_WAIT_L(0); PG8_BAR; PG8_MMA(1, 0, At, B0); PG8_MMA(1, 1, At, B1); PG8_BAR; PG8_SCHED;
            PG8_LDB(B0, 1, 0); PG8_LDB(B1, 1, 1); PG8_SCHED; PG8_LDA(At, 1, 0); PG8_STAGE(PG8_SA(0, 1), a2 + hstep, voffA);
            PG8_WAIT_V(8); PG8_WAIT_L(0); PG8_BAR; PG8_MMA(0, 0, At, B0); PG8_MMA(0, 1, At, B1); PG8_BAR; PG8_SCHED;
            PG8_LDA(At, 1, 1); PG8_STAGE(PG8_SB(1, 0), b3, voffB); PG8_STAGE(PG8_SB(1, 1), b3 + hstep, voffB); PG8_STAGE(PG8_SA(1, 0), a3, voffA);
            PG8_WAIT_V(8); PG8_WAIT_L(0); PG8_BAR; PG8_MMA(1, 0, At, B0); PG8_MMA(1, 1, At, B1); PG8_BAR; PG8_SCHED;
            } else {
            PG8_LDB(B0, 0, 0); PG8_SCHED; PG8_LDA(At, 0, 0); PG8_STAGE(PG8_SA(1, 1), a1 + hstep, voffA);
            PG8_WAIT_L(8); PG8_BAR; PG8_WAIT_L(0); PG8_MMA(0, 0, At, B0); PG8_BAR; PG8_SCHED;
            PG8_LDB(B1, 0, 1); PG8_STAGE(PG8_SB(0, 0), b2, voffB);
            PG8_BAR; PG8_WAIT_L(0); PG8_MMA(0, 1, At, B1); PG8_BAR;
            PG8_LDA(At, 0, 1); PG8_STAGE(PG8_SA(0, 0), a2, voffA);
            PG8_BAR; PG8_WAIT_L(0); PG8_MMA(1, 0, At, B0); PG8_BAR; PG8_SCHED;
            PG8_STAGE(PG8_SB(0, 1), b2 + hstep, voffB);
            PG8_WAIT_V(6); PG8_BAR; PG8_MMA(1, 1, At, B1); PG8_BAR;
            PG8_LDB(B0, 1, 0); PG8_SCHED; PG8_LDA(At, 1, 0); PG8_STAGE(PG8_SA(0, 1), a2 + hstep, voffA);
            PG8_WAIT_L(8); PG8_BAR; PG8_WAIT_L(0); PG8_MMA(0, 0, At, B0); PG8_BAR; PG8_SCHED;
            PG8_LDB(B1, 1, 1); PG8_STAGE(PG8_SB(1, 0), b3, voffB);
            PG8_BAR; PG8_WAIT_L(0); PG8_MMA(0, 1, At, B1); PG8_BAR;
            PG8_LDA(At, 1, 1); PG8_STAGE(PG8_SA(1, 0), a3, voffA);
            PG8_BAR; PG8_WAIT_L(0); PG8_MMA(1, 0, At, B0); PG8_BAR; PG8_SCHED;
            PG8_STAGE(PG8_SB(1, 1), b3 + hstep, voffB);
            PG8_WAIT_V(6); PG8_BAR; PG8_MMA(1, 1, At, B1); PG8_BAR;
            }
        }
        if constexpr (ALIGN_EPI) { if (wr == 0) PG8_BAR; }
        if constexpr (!Epi::AFTER_DRAIN) { E(acc, cur, wr, wc, fr, fq); S.done(cur); }
        if (!has_next) break;
#pragma unroll
        for (int a = 0; a < 2; ++a)
#pragma unroll
            for (int b = 0; b < 2; ++b)
#pragma unroll
                for (int m = 0; m < 4; ++m)
#pragma unroll
                    for (int n = 0; n < 2; ++n) acc[a][b][m][n] = (f32x4){0.f, 0.f, 0.f, 0.f};
        cur = nxt; cA = nA; cB = nB; ++ui;
        if constexpr (ALIGN_EPI) { if (wr == 1) PG8_BAR; }
    }
    PG8_WAIT_V(0);
    if constexpr (!ALIGN_EPI) { if (wr == 0) PG8_BAR; }
    PG8_BAR;
    if constexpr (Epi::AFTER_DRAIN) { E.fused(acc, cur, wr, wc, fr, fq, lds, wid, lane); S.done(cur); }
#undef PG8_SA
#undef PG8_SB
#undef PG8_STAGE
#undef PG8_LDA
#undef PG8_LDB
#undef PG8_MMA
#undef PG8_WAIT_V
#undef PG8_WAIT_L
#undef PG8_BAR
#undef PG8_SCHED
}
}

namespace cg = cooperative_groups;
#define LAS __attribute__((address_space(3)))
typedef unsigned short bf16;
typedef unsigned v4u __attribute__((ext_vector_type(4)));
typedef unsigned v2u __attribute__((ext_vector_type(2)));
typedef float f32x4 __attribute__((ext_vector_type(4)));
typedef short bf16x8 __attribute__((ext_vector_type(8)));
using pg8::cvt_pk_bf16;
typedef float f32x2_t __attribute__((ext_vector_type(2)));
typedef __bf16 bf16x2_t __attribute__((ext_vector_type(2)));
__device__ __forceinline__ unsigned pkc(float lo, float hi) { const f32x2_t v = {lo, hi}; return __builtin_bit_cast(unsigned, __builtin_convertvector(v, bf16x2_t)); }

constexpr int NB = 2, SEQ = 8192, D = 1024, M = NB * SEQ, FF = 2816, NH = 8, NMOD = 9 * D, INW = 8208;
constexpr float EPS = 1e-6f;
constexpr size_t MiB = 1u << 20;
constexpr size_t WS_MOD = 64 * 1024;
constexpr size_t WS_GL = 256 * 1024;
constexpr size_t WS_STATS = 512 * 1024;
constexpr size_t WS_G = 2 * MiB;
constexpr size_t WS_BETA = 1 * MiB + 512 * 1024;
constexpr size_t WS_W = 4 * MiB;
constexpr size_t WS_WBR = 21 * MiB, WS_WOUT = 25 * MiB;
constexpr size_t WS_H = 28 * MiB;
constexpr size_t WS_Q = 60 * MiB, WS_K = 92 * MiB, WS_V = 124 * MiB, WS_Z = 156 * MiB, WS_WW = 188 * MiB, WS_QK = 220 * MiB, WS_TAIL = 156 * MiB;
constexpr size_t WS_ACT = 60 * MiB;
constexpr size_t WS_END = 256 * MiB;
constexpr int LDS_BYTES = 160 * 1024;
#if defined(SKIP_F1)
constexpr float F1SCALE = 0.0f;
#else
constexpr float F1SCALE = 0.5f;
#endif

__device__ __forceinline__ float bf2f(unsigned short h) { return __uint_as_float((unsigned)h << 16); }
__device__ __forceinline__ float wave_sum(float v) {
#pragma unroll
    for (int o = 1; o < 64; o <<= 1) v += __shfl_xor(v, o);
    return v;
}
#define LDS_WAIT() asm volatile("s_waitcnt lgkmcnt(0)" ::: "memory")
#define WG_BAR() do { asm volatile("s_waitcnt lgkmcnt(0)" ::: "memory"); __builtin_amdgcn_s_barrier(); asm volatile("" ::: "memory"); } while (0)


#define RLX_AGENT __ATOMIC_RELAXED, __HIP_MEMORY_SCOPE_AGENT
#define XB_TMO      128
#define XB_XCNT(j)  (256  + 64 * (j))
#define XB_XSUB(j)  (1280 + 64 * (j))
#define XB_XGEN(j)  (2304 + 64 * (j))
#define XB_TOP      3328
#define XB_TOPGEN   3392
#define XCD_BAR_WORDS 3456
#define XB_SPIN_CAP (1u << 18)

__device__ __forceinline__ unsigned xb_ld(unsigned* p)              { return __hip_atomic_load(p, __ATOMIC_RELAXED, __HIP_MEMORY_SCOPE_AGENT); }
__device__ __forceinline__ unsigned xb_add(unsigned* p, unsigned v) { return __hip_atomic_fetch_add(p, v, __ATOMIC_RELAXED, __HIP_MEMORY_SCOPE_AGENT); }
__device__ __forceinline__ unsigned xb_xcc_id() { return (unsigned)__builtin_amdgcn_s_getreg((3 << 11) | 20) & 0xFu; }
#define XB_SPIN(cond, bar) do { unsigned _sp = 0; while (cond) { __builtin_amdgcn_s_sleep(1); \
    if ((++_sp & 255u) == 0u) { if (xb_ld(&(bar)[XB_TMO])) break; if (_sp > XB_SPIN_CAP) { atomicAdd(&(bar)[XB_TMO], 1u); break; } } } } while (0)

struct XcdBarrier {
    unsigned* bar; unsigned x;
    volatile LAS unsigned* st;
};

__device__ __forceinline__ XcdBarrier xcd_barrier_post(unsigned* bar, volatile LAS unsigned* st) {
    XcdBarrier b; b.bar = bar; b.x = xb_xcc_id(); b.st = st;
    if (threadIdx.x == 0) (void)xb_add(&bar[XB_XCNT(b.x)], 1u);
    return b;
}
__device__ __forceinline__ void xcd_barrier_complete(unsigned* bar, unsigned x, unsigned& nloc, unsigned& nx) {
    const unsigned G = gridDim.x * gridDim.y * gridDim.z;
    unsigned sum, cnt, mine, sp = 0u;
    for (;;) {
        sum = 0u; cnt = 0u; mine = 0u;
#pragma unroll
        for (unsigned j = 0; j < 16; ++j) { const unsigned c = xb_ld(&bar[XB_XCNT(j)]); sum += c; cnt += (c > 0u) ? 1u : 0u; mine = (j == x) ? c : mine; }
        if (sum == G) break;
        __builtin_amdgcn_s_sleep(1);
        if ((++sp & 255u) == 0u) { if (xb_ld(&bar[XB_TMO])) break; if (sp > XB_SPIN_CAP) { atomicAdd(&bar[XB_TMO], 1u); break; } }
    }
    nloc = mine > 0u ? mine : 1u; nx = cnt > 0u ? cnt : 1u;
}

__device__ __forceinline__ void xcd_barrier(const XcdBarrier& b) {
    asm volatile("s_waitcnt vmcnt(0)" ::: "memory");
    __syncthreads();
    if (threadIdx.x == 0) {
        unsigned* bar = b.bar;
        __builtin_amdgcn_s_waitcnt(0);
        unsigned nloc = b.st[0], nx = b.st[1];
        if (nloc == 0u) { xcd_barrier_complete(bar, b.x, nloc, nx); b.st[0] = nloc; b.st[1] = nx; }
        const unsigned old = xb_add(&bar[XB_XSUB(b.x)], 1u);
        const unsigned gen = old / nloc;
        if (old + 1u == (gen + 1u) * nloc) {
            __builtin_amdgcn_fence(__ATOMIC_RELEASE, "agent");
            asm volatile("s_waitcnt vmcnt(0)" ::: "memory");
            const unsigned og = xb_add(&bar[XB_TOP], 1u);
            const unsigned tg = og / nx;
            if (og + 1u == (tg + 1u) * nx) xb_add(&bar[XB_TOPGEN], 1u);
            else XB_SPIN(xb_ld(&bar[XB_TOPGEN]) == tg, bar);
            __builtin_amdgcn_fence(__ATOMIC_ACQUIRE, "agent");
            xb_add(&bar[XB_XGEN(b.x)], 1u);
            asm volatile("s_waitcnt vmcnt(0)" ::: "memory");
        } else {
            XB_SPIN(xb_ld(&bar[XB_XGEN(b.x)]) == gen, bar);
            __builtin_amdgcn_fence(__ATOMIC_ACQUIRE, "agent");
            asm volatile("s_waitcnt vmcnt(0)" ::: "memory");
        }
    }
    __syncthreads();
}

__device__ __forceinline__ void tr_tile(const float* W, int ldw, int k0, int ns0, bf16* WT, int K, int nd0, LAS float* scr, int lane) {
#pragma unroll 8
    for (int i = 0; i < 32; ++i) { const int kk = 2 * i + (lane >> 5); scr[kk * 33 + (lane & 31)] = W[(size_t)(k0 + kk) * ldw + ns0 + (lane & 31)]; }
    LDS_WAIT(); asm volatile("" ::: "memory");
    const int c = lane & 7;
#pragma unroll
    for (int j = 0; j < 4; ++j) { const int n = (lane >> 3) + 8 * j; const LAS float* s = scr + (8 * c) * 33 + n;
        v4u o; o.x = cvt_pk_bf16(s[0 * 33], s[1 * 33]); o.y = cvt_pk_bf16(s[2 * 33], s[3 * 33]); o.z = cvt_pk_bf16(s[4 * 33], s[5 * 33]); o.w = cvt_pk_bf16(s[6 * 33], s[7 * 33]);
        *(v4u*)(WT + (size_t)(nd0 + n) * K + k0 + 8 * c) = o; }
    LDS_WAIT(); asm volatile("" ::: "memory");
}
__device__ __forceinline__ void conv_ffn_in(const float* W, bf16* WT, int item, LAS float* scr, int lane) {
    const int kb = item / 176, nb = item % 176, c = 32 * nb; const int half = c >= FF ? 1 : 0, j = c - half * FF;
    tr_tile(W, 2 * FF, 64 * kb, c, WT, D, 256 * (j >> 7) + 128 * half + (j & 127), scr, lane);
}
__device__ __forceinline__ void conv_plain(const float* W, int Kdim, int Ndim, bf16* WT, int item, LAS float* scr, int lane) {
    const int nblk = Ndim / 32, kb = item / nblk, nb = item % nblk;
    tr_tile(W, Ndim, 64 * kb, 32 * nb, WT, Kdim, 32 * nb, scr, lane);
}
__device__ __forceinline__ void conv_inproj(const float* W, bf16* WT, int item, LAS float* scr, int lane) {
    const int kb = item >> 8, nd0 = 32 * (item & 255); const int ns0 = nd0 < 3072 ? nd0 + 2048 : (nd0 < 5120 ? nd0 - 3072 : (nd0 < 7168 ? nd0 + 1040 : nd0 - 2048));
    tr_tile(W, INW, 64 * kb, ns0, WT, D, nd0, scr, lane);
}

template <int MODE>
__device__ __forceinline__ void norm_rows(const float* xin, const float* gain, const float* mod, int sh_off, int sc_off, bf16* H, int gw, int NGW, int lane,
                                          const LAS float* wabT, const float* a_log, const float* dt_bias, float* Gd, float* Bd) {
    int curb = -1; f32x4 cA[4], cB[4];
    for (int m = gw; m < M; m += NGW) {
        const int b = m >> 13;
        if (b != curb) { curb = b;
#pragma unroll
            for (int j = 0; j < 4; ++j) { const int c = 4 * lane + 256 * j; const f32x4 gv = *(const f32x4*)(gain + c), sc = *(const f32x4*)(mod + b * NMOD + sc_off + c);
                cA[j] = gv * (sc + 1.0f); cB[j] = *(const f32x4*)(mod + b * NMOD + sh_off + c); } }
        const f32x4* xr = (const f32x4*)(xin + (size_t)m * D) + lane; f32x4 v[4]; float ss = 0.f;
#pragma unroll
        for (int j = 0; j < 4; ++j) { v[j] = xr[64 * j]; ss += (v[j].x * v[j].x + v[j].y * v[j].y) + (v[j].z * v[j].z + v[j].w * v[j].w); }
        const float r = 1.0f / sqrtf(wave_sum(ss) * (1.0f / D) + EPS);
        v2u* o8 = (v2u*)(H + (size_t)m * D) + lane;
#pragma unroll
        for (int j = 0; j < 4; ++j) { v[j] = v[j] * r * cA[j] + cB[j]; v2u w; w.x = cvt_pk_bf16(v[j].x, v[j].y); w.y = cvt_pk_bf16(v[j].z, v[j].w); o8[64 * j] = w; }
        if (MODE == 1) {
            float mine = 0.f;
            LAS float* red = (LAS float*)((LAS unsigned char*)wabT + 65536) + (lane * 0 + __builtin_amdgcn_readfirstlane(threadIdx.x >> 6)) * 1040;
#pragma unroll
            for (int c = 0; c < 16; ++c) { float a = 0.f;
#pragma unroll
                for (int j = 0; j < 4; ++j) { const f32x4 w = *(const LAS f32x4*)(wabT + c * 1024 + 4 * lane + 256 * j); a += (v[j].x * w.x + v[j].y * w.y) + (v[j].z * w.z + v[j].w * w.w); }
                red[c * 65 + lane] = a; }
            asm volatile("s_waitcnt lgkmcnt(0)" ::: "memory");
            if (lane < 16) { float s0 = 0.f, s1 = 0.f, s2 = 0.f, s3 = 0.f;
#pragma unroll
                for (int j = 0; j < 64; j += 4) { s0 += red[lane * 65 + j]; s1 += red[lane * 65 + j + 1]; s2 += red[lane * 65 + j + 2]; s3 += red[lane * 65 + j + 3]; }
                mine = (s0 + s1) + (s2 + s3); }
            asm volatile("s_waitcnt lgkmcnt(0)" ::: "memory");
            { const int hh = lane & 7; const float xv = mine + dt_bias[hh]; const float sp = fmaxf(xv, 0.f) + log1pf(__expf(-fabsf(xv)));
              const float gval = -__expf(a_log[hh]) * sp, bval = 1.0f / (1.0f + __expf(-mine));
              if (lane < 16) Gd[(size_t)m * 16 + lane] = (lane < 8) ? gval : bval; }
        }
    }
}


#if defined(DIAG_W)
__device__ __forceinline__ void zprobe(const bf16* Vs_, size_t tok0, int h, int ht, int lane, unsigned* word) {
    if (ht < 64) { float m = fabsf(bf2f(Vs_[16777216 + (tok0 + ht) * 1024 + h * 128 + 5]));
        for (int o = 1; o < 64; o <<= 1) m = fmaxf(m, __shfl_xor(m, o));
        if (lane == 0) atomicMax(word, __float_as_uint(1.0f / (m + 1e-6f))); }
}
#endif
#if defined(NO_TAIL)
#define NOTAIL_FLAG false
#else
#define NOTAIL_FLAG true
#endif
constexpr int DL_HALF = 69632;
template <int MODE>
__device__ __forceinline__ void dn_local_phase(LAS unsigned char* L, bf16* Qs, bf16* Ks, bf16* Vs, bf16* WWs, bf16* QKs, bf16* Qp, const float* Gd, const float* Bd, float* GL,
                                               const float* conv_w, int tid, int nblk, int bid) {
    const int wv = __builtin_amdgcn_readfirstlane((tid >> 6) & 3);
    for (int it = bid; it < 1024; it += nblk) {
        int tidv = tid; asm volatile("" : "+v"(tidv));
        const int hw = tidv >> 8, ht = tidv & 255, lane = tidv & 63, fr = lane & 15, fq = lane >> 4;
        LAS unsigned char* Lh = L + hw * DL_HALF;
        LAS float* AM = (LAS float*)(Lh + 52224);
        LAS float* gcs = (LAS float*)(Lh + 68608); LAS float* bts = gcs + 64; LAS float* egs = gcs + 128; LAS float* gcs2 = gcs + 192;
        LAS float* cwl = (LAS float*)(L + 2 * DL_HALF + hw * 6144);
        const int unit = it * 2 + hw, h = unit & 7, n = (unit >> 3) & 127, b = unit >> 10;
        const size_t tok0 = (size_t)b * SEQ + 64 * n;
        __syncthreads();
        if (MODE == 2 && ht < 64) { gcs[ht] = Gd[(tok0 + ht) * 16 + h]; bts[ht] = Gd[(tok0 + ht) * 16 + 8 + h]; }
        if (MODE == 0 || MODE == 2) {
#pragma unroll
            for (int k12 = 0; k12 < 12; ++k12) { const int idx = ht + 256 * k12, T = idx >> 10, r = (idx >> 4) & 63, ch = idx & 15;
                const bf16* sp = (T == 0 ? Qs : (T == 1 ? Ks : Vs)) + (tok0 + r) * 1024 + h * 128 + ch * 8;
                *(LAS v4u*)(Lh + T * 18224 + (r + 3) * 272 + ch * 16) = *(const v4u*)sp; }
            if (ht < 144) { const int T = ht / 48, rem = ht - T * 48, r = rem >> 4, ch = rem & 15;
                v4u val = (v4u){0u, 0u, 0u, 0u};
#if !defined(NO_HALO)
                if (n > 0) { if (MODE == 2) val = *(const v4u*)(Qp + ((size_t)((b * 128 + n - 1) * 3 + r)) * 3072 + T * 1024 + h * 128 + ch * 8);
                             else val = *(const v4u*)((T == 0 ? Qs : (T == 1 ? Ks : Vs)) + (tok0 - 3 + r) * 1024 + h * 128 + ch * 8); }
#endif
                *(LAS v4u*)(Lh + T * 18224 + r * 272 + ch * 16) = val; }
            for (int c = ht; c < 384; c += 256) { const int j = c / 96, rem = c - j * 96, T = rem >> 5, ch4 = rem & 31;
                *(LAS f32x4*)(cwl + (j * 3 + T) * 128 + ch4 * 4) = *(const f32x4*)(conv_w + (size_t)j * 3072 + T * 1024 + h * 128 + ch4 * 4); }
        } else {
            if (ht < 64) { gcs[ht] = Gd[(tok0 + ht) * 16 + h]; bts[ht] = Gd[(tok0 + ht) * 16 + 8 + h]; }
#pragma unroll
            for (int k12 = 0; k12 < 12; ++k12) { const int idx = ht + 256 * k12, T = idx >> 10, r = (idx >> 4) & 63, ch = idx & 15;
                const bf16* sp = (T == 0 ? Qp : (T == 1 ? WWs : QKs)) + (tok0 + r) * 1024 + h * 128 + ch * 8;
                *(LAS v4u*)(Lh + T * 17408 + r * 272 + ch * 16) = *(const v4u*)sp; }
        }
        __syncthreads();
        if (MODE != 0 && ht < 64) { float acc_g = 0.f;
#pragma unroll 8
            for (int j = 0; j < 64; ++j) { const float gj = gcs[j]; acc_g += (j <= ht) ? gj : 0.f; }
            gcs2[ht] = acc_g; egs[ht] = __expf(acc_g);
            if (ht == 63) GL[(b * 8 + h) * 128 + n] = __expf(acc_g); }
        if (MODE == 0 || MODE == 2) {
        const int ti = ht >> 2, tq = ht & 3;
        unsigned outp[3][16];
        {
#pragma unroll
            for (int T = 0; T < 3; ++T) {
                float y[32]; float ss = 0.f;
#pragma unroll
                for (int cgp = 0; cgp < 4; ++cgp) { const int ch0 = tq * 32 + cgp * 8; float a[8];
#pragma unroll
                    for (int e = 0; e < 8; ++e) a[e] = 0.f;
#pragma unroll
                    for (int j = 0; j < 4; ++j) { const v4u xv = *(const LAS v4u*)(Lh + T * 18224 + (ti + j) * 272 + ch0 * 2);
                        const LAS float* wp = cwl + (j * 3 + T) * 128 + ch0; const f32x4 w0 = *(const LAS f32x4*)wp, w1 = *(const LAS f32x4*)(wp + 4);
                        a[0] += w0.x * __uint_as_float(xv.x << 16); a[1] += w0.y * __uint_as_float(xv.x & 0xffff0000u); a[2] += w0.z * __uint_as_float(xv.y << 16); a[3] += w0.w * __uint_as_float(xv.y & 0xffff0000u);
                        a[4] += w1.x * __uint_as_float(xv.z << 16); a[5] += w1.y * __uint_as_float(xv.z & 0xffff0000u); a[6] += w1.z * __uint_as_float(xv.w << 16); a[7] += w1.w * __uint_as_float(xv.w & 0xffff0000u); }
#pragma unroll
                    for (int e = 0; e < 8; ++e) { const float s = a[e] / (1.0f + __expf(-a[e])); y[cgp * 8 + e] = s; ss += s * s; } }
                float scl = 1.0f;
                if (T < 2) { ss += __shfl_xor(ss, 1); ss += __shfl_xor(ss, 2); scl = 1.0f / sqrtf(ss + EPS); if (T == 0) scl *= 0.08838834764831845f; }
#if defined(DIAG_W)
                if (T == 1) atomicMax((unsigned*)GL + 4004 - 65536, __float_as_uint(ss * scl * scl));
#endif
#pragma unroll
                for (int e = 0; e < 16; ++e) outp[T][e] = cvt_pk_bf16(y[2 * e] * scl, y[2 * e + 1] * scl);
            }
        }
        if (MODE == 0) {
#if defined(P6A_INPLACE)
#pragma unroll
        for (int T = 0; T < 3; ++T) { bf16* dp = (T == 0 ? Qs : (T == 1 ? Ks : Vs)) + (tok0 + ti) * 1024 + h * 128 + tq * 32;
#else
#pragma unroll
        for (int T = 0; T < 3; ++T) { bf16* dp = (T == 0 ? Qp : (T == 1 ? WWs : QKs)) + (tok0 + ti) * 1024 + h * 128 + tq * 32;
#endif
#pragma unroll
            for (int k4 = 0; k4 < 4; ++k4) { const v4u ov = (v4u){outp[T][4 * k4], outp[T][4 * k4 + 1], outp[T][4 * k4 + 2], outp[T][4 * k4 + 3]};
#if defined(NO_P6A_STORE)
                if (ov.x == 0x12345678u) *(v4u*)(dp + k4 * 8) = ov;
#else
                *(v4u*)(dp + k4 * 8) = ov;
#endif
            } }
        continue;
        }
        __syncthreads();
#pragma unroll
        for (int T = 0; T < 3; ++T)
#pragma unroll
            for (int k4 = 0; k4 < 4; ++k4) *(LAS v4u*)(Lh + T * 17408 + ti * 272 + tq * 64 + k4 * 16) = (v4u){outp[T][4 * k4], outp[T][4 * k4 + 1], outp[T][4 * k4 + 2], outp[T][4 * k4 + 3]};
        }
        __syncthreads();
        {
            bf16x8 ak[4], aq[4];
#if defined(DIAG_W)
            float dam = 0.f, dkk = 0.f;
#endif
#pragma unroll
            for (int s = 0; s < 4; ++s) { ak[s] = *(const LAS bf16x8*)(Lh + 17408 + (16 * wv + fr) * 272 + s * 64 + fq * 16); aq[s] = *(const LAS bf16x8*)(Lh + (16 * wv + fr) * 272 + s * 64 + fq * 16); }
            bf16* qkp = QKs + tok0 * 1024 + h * 128;
#pragma unroll
            for (int jt = 0; jt < 4; ++jt) { f32x4 ckk = (f32x4){0.f, 0.f, 0.f, 0.f}, cqk = (f32x4){0.f, 0.f, 0.f, 0.f};
#pragma unroll
                for (int s = 0; s < 4; ++s) { const bf16x8 bk = *(const LAS bf16x8*)(Lh + 17408 + (16 * jt + fr) * 272 + s * 64 + fq * 16);
                    ckk = __builtin_amdgcn_mfma_f32_16x16x32_bf16(ak[s], bk, ckk, 0, 0, 0); cqk = __builtin_amdgcn_mfma_f32_16x16x32_bf16(aq[s], bk, cqk, 0, 0, 0); }
                const int j = 16 * jt + fr; const float gj = gcs2[j];
#pragma unroll
                for (int r = 0; r < 4; ++r) { const int i = 16 * wv + 4 * fq + r; const float e = __expf(fminf(gcs2[i] - gj, 0.f));
                    AM[i * 64 + j] = (j < i) ? ckk[r] * bts[i] * e : 0.f;
#if defined(DIAG_W)
                    dam = fmaxf(dam, (j < i) ? fabsf(ckk[r] * bts[i] * e) : 0.f); dkk = fmaxf(dkk, fabsf(ckk[r]));
#endif
#if !defined(P6_SKIP_QK)
                    qkp[(size_t)i * 1024 + j] = (bf16)(cvt_pk_bf16((j <= i) ? cqk[r] * e : 0.f, 0.f) & 0xffffu);
#endif
                    } }
#if defined(DIAG_W)
            atomicMax((unsigned*)GL + 4001 - 65536, __float_as_uint(dam)); atomicMax((unsigned*)GL + 4002 - 65536, __float_as_uint(dkk));
#endif
        }
        __syncthreads();
        {
            const float gl = gcs2[63];
#pragma unroll
            for (int k4 = 0; k4 < 4; ++k4) { const int idx = ht + 256 * k4, row = idx >> 4, ch = idx & 15; const v4u q8 = *(const LAS v4u*)(Lh + row * 272 + ch * 16); const float e = egs[row];
                v4u o; o.x = cvt_pk_bf16(__uint_as_float(q8.x << 16) * e, __uint_as_float(q8.x & 0xffff0000u) * e); o.y = cvt_pk_bf16(__uint_as_float(q8.y << 16) * e, __uint_as_float(q8.y & 0xffff0000u) * e);
                o.z = cvt_pk_bf16(__uint_as_float(q8.z << 16) * e, __uint_as_float(q8.z & 0xffff0000u) * e); o.w = cvt_pk_bf16(__uint_as_float(q8.w << 16) * e, __uint_as_float(q8.w & 0xffff0000u) * e);
#if !defined(P6_SKIP_QD)
                *(v4u*)(Qs + (tok0 + row) * 1024 + h * 128 + ch * 8) = o;
#endif
                }
#pragma unroll
            for (int k4 = 0; k4 < 4; ++k4) { const int idx = ht + 256 * k4, d = idx & 127, cb = idx >> 7; float kv[8];
#pragma unroll
                for (int e = 0; e < 8; ++e) { const int c = 8 * cb + e; kv[e] = bf2f(*(const LAS unsigned short*)(Lh + 17408 + c * 272 + d * 2)) * __expf(gl - gcs2[c]); }
                v4u o; o.x = cvt_pk_bf16(kv[0], kv[1]); o.y = cvt_pk_bf16(kv[2], kv[3]); o.z = cvt_pk_bf16(kv[4], kv[5]); o.w = cvt_pk_bf16(kv[6], kv[7]);
#if !defined(P6_SKIP_KD)
                *(v4u*)(Ks + (tok0 + (d >> 1)) * 1024 + h * 128 + (d & 1) * 64 + 8 * cb) = o;
#endif
                }
        }
#if defined(DIAG_W)
        asm volatile("s_waitcnt vmcnt(0)" ::: "memory"); zprobe(Vs, tok0, h, ht, lane, (unsigned*)GL + 4017 - 65536);
#endif
        {
            const bool isU = ht < 128; const int xc = ht & 127;
            const LAS unsigned short* src = (const LAS unsigned short*)(Lh + (isU ? 34816 : 17408)) + xc;
            __attribute__((address_space(1))) bf16* dst = (__attribute__((address_space(1))) bf16*)((isU ? Vs : WWs) + tok0 * 1024 + h * 128 + xc);
            float sol[64];
#if defined(DIAG_W)
            float dmx = 0.f, dmu = 0.f;
#endif
#pragma unroll
            for (int i = 0; i < 64; ++i) {
                float s = bf2f(src[i * 136]) * bts[i]; if (!isU) s *= egs[i];
#if defined(ZERO_T012)
                if (i < 3) s = 0.f;
#endif
#if !defined(NO_AM)
#pragma unroll
                for (int j = 0; j < i; ++j) s = fmaf(-AM[i * 64 + j], sol[j], s);
#endif
                sol[i] = s;
#if defined(DIAG_W)
                if (!isU) dmx = fmaxf(dmx, fabsf(s)); else dmu = fmaxf(dmu, fabsf(s));
#endif
#if !defined(P6_SKIP_SOLVE)
                *dst = (bf16)(cvt_pk_bf16(s, 0.f) & 0xffffu);
#endif
                dst += 1024;
                asm volatile("" : "+v"(dst) :: "memory");
            }
#if defined(DIAG_W)
            atomicMax((unsigned*)GL + 4000 - 65536 + 0, __float_as_uint(dmx));
            atomicMax((unsigned*)GL + 4003 - 65536, __float_as_uint(dmu));
#endif
#if defined(DIAG_W)
            asm volatile("s_waitcnt vmcnt(0)" ::: "memory"); zprobe(Vs, tok0, h, ht, lane, (unsigned*)GL + 4018 - 65536);
#endif
        }
    }
}

constexpr int SC_STAGE = 62464, SC_ST = 2 * SC_STAGE, SC_VNT = SC_ST + 8704;
struct ScSet { v4u pw[2], pq[2], pk[2], pqk; v2u pu[2]; float gl; };
__device__ __forceinline__ void dn_scan_phase(LAS unsigned char* L, const bf16* Qs, const bf16* Ks, bf16* Vs, const bf16* WWs, const bf16* QKs, const float* GL, int tid, int bid) {
    constexpr int NVT = 1, VS = 16 * NVT;
    if (bid >= 128) return;
    const int xcd = bid & 7, rr = bid >> 3, sl = rr & 7, p = xcd + 8 * (rr >> 3), b = p >> 3, h = p & 7;
    const int w = __builtin_amdgcn_readfirstlane(tid >> 6), lane = tid & 63, fr = lane & 15, fq = lane >> 4;
    const size_t rowb = (size_t)b * SEQ;
    LAS unsigned char* ST = L + SC_ST; LAS unsigned char* VNT = L + SC_VNT;
    for (int i = tid; i < 8704 / 4; i += 512) ((LAS unsigned*)ST)[i] = 0u;
    f32x4 accS[2]; accS[0] = (f32x4){0.f, 0.f, 0.f, 0.f}; accS[1] = accS[0];
    const int r16 = tid >> 4, c16 = tid & 15;
    const int r8 = tid >> 3, c8 = tid & 7;
#define SC_LOADS(S, nn) do { const size_t t0 = rowb + 64 * (nn); \
        S.pw[0] = *(const v4u*)(WWs + (t0 + r16) * 1024 + h * 128 + c16 * 8); S.pw[1] = *(const v4u*)(WWs + (t0 + r16 + 32) * 1024 + h * 128 + c16 * 8); \
        S.pq[0] = *(const v4u*)(Qs + (t0 + r16) * 1024 + h * 128 + c16 * 8); S.pq[1] = *(const v4u*)(Qs + (t0 + r16 + 32) * 1024 + h * 128 + c16 * 8); \
        S.pk[0] = *(const v4u*)(Ks + (t0 + (r8 >> 1)) * 1024 + h * 128 + (r8 & 1) * 64 + c8 * 8); S.pk[1] = *(const v4u*)(Ks + (t0 + 32 + (r8 >> 1)) * 1024 + h * 128 + (r8 & 1) * 64 + c8 * 8); \
        S.pqk = *(const v4u*)(QKs + (t0 + r8) * 1024 + h * 128 + c8 * 8); \
        if (w < 4) { S.pu[0] = *(const v2u*)(Vs + (t0 + 16 * w + fr) * 1024 + h * 128 + VS * sl + 4 * fq); if (NVT == 2) S.pu[1] = *(const v2u*)(Vs + (t0 + 16 * w + fr) * 1024 + h * 128 + VS * sl + 16 + 4 * fq); } \
        S.gl = GL[(b * 8 + h) * 128 + (nn)]; } while (0)
#define SC_WRITES(S, buf) do { LAS unsigned char* Sw = L + (buf) * SC_STAGE; \
        *(LAS v4u*)(Sw + r16 * 272 + c16 * 16) = S.pw[0]; *(LAS v4u*)(Sw + (r16 + 32) * 272 + c16 * 16) = S.pw[1]; \
        *(LAS v4u*)(Sw + 17408 + r16 * 272 + c16 * 16) = S.pq[0]; *(LAS v4u*)(Sw + 17408 + (r16 + 32) * 272 + c16 * 16) = S.pq[1]; \
        *(LAS v4u*)(Sw + 34816 + r8 * 144 + c8 * 16) = S.pk[0]; *(LAS v4u*)(Sw + 34816 + (r8 + 64) * 144 + c8 * 16) = S.pk[1]; \
        *(LAS v4u*)(Sw + 53248 + r8 * 144 + c8 * 16) = S.pqk; } while (0)
    ScSet R0, R1, R2;
    R0.pu[0] = (v2u){0u, 0u}; R0.pu[1] = R0.pu[0]; R1.pu[0] = R0.pu[0]; R1.pu[1] = R0.pu[0]; R2.pu[0] = R0.pu[0]; R2.pu[1] = R0.pu[0];
    SC_LOADS(R0, 0); SC_WRITES(R0, 0);
    v2u ucur[2]; ucur[0] = R0.pu[0]; ucur[1] = R0.pu[1]; float gl = R0.gl;
    v2u unext[2]; unext[0] = ucur[0]; unext[1] = ucur[1]; float gnext = gl;
    SC_LOADS(R1, 1); SC_LOADS(R2, 2); SC_LOADS(R0, 3);
    __syncthreads();
#define SC_STEP(n, SW) do { LAS unsigned char* Sg = L + ((n) & 1) * SC_STAGE; \
        if ((n) + 1 < 128) { SC_WRITES(SW, ((n) + 1) & 1); unext[0] = SW.pu[0]; unext[1] = SW.pu[1]; gnext = SW.gl; } \
        if ((n) + 4 < 128) SC_LOADS(SW, (n) + 4); \
        f32x4 acc[2]; acc[0] = (f32x4){0.f, 0.f, 0.f, 0.f}; acc[1] = acc[0]; \
        { const LAS unsigned char* Arow = Sg + (w < 4 ? 0 : 17408) + (16 * (w & 3) + fr) * 272 + fq * 16; \
          _Pragma("unroll") for (int s = 0; s < 4; ++s) { const bf16x8 bfr = *(const LAS bf16x8*)(Arow + s * 64); \
            _Pragma("unroll") for (int vt = 0; vt < NVT; ++vt) { const bf16x8 afr = *(const LAS bf16x8*)(ST + (16 * vt + fr) * 272 + s * 64 + fq * 16); acc[vt] = __builtin_amdgcn_mfma_f32_16x16x32_bf16(afr, bfr, acc[vt], 0, 0, 0); } } } \
        if (w < 4) { _Pragma("unroll") for (int vt = 0; vt < NVT; ++vt) { \
            const float u0 = __uint_as_float(ucur[vt].x << 16), u1 = __uint_as_float(ucur[vt].x & 0xffff0000u), u2 = __uint_as_float(ucur[vt].y << 16), u3 = __uint_as_float(ucur[vt].y & 0xffff0000u); \
            const unsigned p0 = pkc(u0 - acc[vt][0], u1 - acc[vt][1]), p1 = pkc(u2 - acc[vt][2], u3 - acc[vt][3]); \
            LAS unsigned short* vp = (LAS unsigned short*)(VNT + (16 * vt + 4 * fq) * 144 + (16 * w + fr) * 2); \
            vp[0] = (unsigned short)(p0 & 0xffffu); vp[72] = (unsigned short)(p0 >> 16); vp[144] = (unsigned short)(p1 & 0xffffu); vp[216] = (unsigned short)(p1 >> 16); } } \
        WG_BAR(); \
        { accS[0] = accS[0] * gl; accS[1] = accS[1] * gl; \
          _Pragma("unroll") for (int s = 0; s < 2; ++s) { const bf16x8 afr = *(const LAS bf16x8*)(Sg + 34816 + (16 * w + fr) * 144 + s * 64 + fq * 16); \
            _Pragma("unroll") for (int vt = 0; vt < NVT; ++vt) { const bf16x8 bfr = *(const LAS bf16x8*)(VNT + (16 * vt + fr) * 144 + s * 64 + fq * 16); accS[vt] = __builtin_amdgcn_mfma_f32_16x16x32_bf16(afr, bfr, accS[vt], 0, 0, 0); } } \
          _Pragma("unroll") for (int vt = 0; vt < NVT; ++vt) { v2u o; o.x = pkc(accS[vt][0], accS[vt][1]); o.y = pkc(accS[vt][2], accS[vt][3]); *(LAS v2u*)(ST + (16 * vt + fr) * 272 + (16 * w + 4 * fq) * 2) = o; } } \
        if (w >= 4) { \
          _Pragma("unroll") for (int s = 0; s < 2; ++s) { const bf16x8 bfr = *(const LAS bf16x8*)(Sg + 53248 + (16 * (w - 4) + fr) * 144 + s * 64 + fq * 16); \
            _Pragma("unroll") for (int vt = 0; vt < NVT; ++vt) { const bf16x8 afr = *(const LAS bf16x8*)(VNT + (16 * vt + fr) * 144 + s * 64 + fq * 16); acc[vt] = __builtin_amdgcn_mfma_f32_16x16x32_bf16(afr, bfr, acc[vt], 0, 0, 0); } } \
          _Pragma("unroll") for (int vt = 0; vt < NVT; ++vt) { v2u o; o.x = pkc(acc[vt][0], acc[vt][1]); o.y = pkc(acc[vt][2], acc[vt][3]); \
            *(v2u*)(Vs + (rowb + 64 * (n) + 16 * (w - 4) + fr) * 1024 + h * 128 + VS * sl + 16 * vt + 4 * fq) = o; } } \
        ucur[0] = unext[0]; ucur[1] = unext[1]; gl = gnext; \
        WG_BAR(); } while (0)
    for (int n3 = 0; n3 < 126; n3 += 3) { SC_STEP(n3, R1); SC_STEP(n3 + 1, R2); SC_STEP(n3 + 2, R0); }
    SC_STEP(126, R1); SC_STEP(127, R2);
#undef SC_STEP
#undef SC_LOADS
#undef SC_WRITES
}

__device__ __forceinline__ void post_rows(const bf16* Va, float* STATS, const bf16* Os, bf16* Zs, const float* norm_g, int gw, int NGW, int lane) {
    float ng[16];
#pragma unroll
    for (int e = 0; e < 16; ++e) ng[e] = norm_g[((16 * lane) & 127) + e];
    for (int m = gw; m < M; m += NGW) {
        { const v4u a = *((const v4u*)(Va + (size_t)m * D) + lane), c = *((const v4u*)(Va + (size_t)m * D) + 64 + lane); float x[16];
          x[0] = __uint_as_float(a.x << 16); x[1] = __uint_as_float(a.x & 0xffff0000u); x[2] = __uint_as_float(a.y << 16); x[3] = __uint_as_float(a.y & 0xffff0000u);
          x[4] = __uint_as_float(a.z << 16); x[5] = __uint_as_float(a.z & 0xffff0000u); x[6] = __uint_as_float(a.w << 16); x[7] = __uint_as_float(a.w & 0xffff0000u);
          x[8] = __uint_as_float(c.x << 16); x[9] = __uint_as_float(c.x & 0xffff0000u); x[10] = __uint_as_float(c.y << 16); x[11] = __uint_as_float(c.y & 0xffff0000u);
          x[12] = __uint_as_float(c.z << 16); x[13] = __uint_as_float(c.z & 0xffff0000u); x[14] = __uint_as_float(c.w << 16); x[15] = __uint_as_float(c.w & 0xffff0000u);
          float s = 0.f;
#pragma unroll
          for (int e = 0; e < 16; ++e) s += x[e];
#if defined(DIAG_W)
          { float mv = 0.f; for (int e = 0; e < 16; ++e) mv = fmaxf(mv, fabsf(x[e])); atomicMax((unsigned*)STATS - 131072 + 4019, __float_as_uint(mv)); }
#endif
          const float mu = wave_sum(s) * (1.0f / D); float q = 0.f;
#pragma unroll
          for (int e = 0; e < 16; ++e) { const float d = x[e] - mu; q += d * d; }
          const float rstd = 1.0f / sqrtf(wave_sum(q) * (1.0f / D) + EPS);
          if (lane == 0) { STATS[(size_t)m * 2] = mu; STATS[(size_t)m * 2 + 1] = rstd; } }
        { const v4u* op = (const v4u*)(Os + (size_t)m * D + 16 * lane); v4u* zp = (v4u*)(Zs + (size_t)m * D + 16 * lane);
#if defined(Z_ATOMIC)
          v4u z0, z1; { const unsigned* zq = (const unsigned*)zp;
            z0.x = __hip_atomic_load(zq + 0, __ATOMIC_RELAXED, __HIP_MEMORY_SCOPE_AGENT); z0.y = __hip_atomic_load(zq + 1, __ATOMIC_RELAXED, __HIP_MEMORY_SCOPE_AGENT); z0.z = __hip_atomic_load(zq + 2, __ATOMIC_RELAXED, __HIP_MEMORY_SCOPE_AGENT); z0.w = __hip_atomic_load(zq + 3, __ATOMIC_RELAXED, __HIP_MEMORY_SCOPE_AGENT);
            z1.x = __hip_atomic_load(zq + 4, __ATOMIC_RELAXED, __HIP_MEMORY_SCOPE_AGENT); z1.y = __hip_atomic_load(zq + 5, __ATOMIC_RELAXED, __HIP_MEMORY_SCOPE_AGENT); z1.z = __hip_atomic_load(zq + 6, __ATOMIC_RELAXED, __HIP_MEMORY_SCOPE_AGENT); z1.w = __hip_atomic_load(zq + 7, __ATOMIC_RELAXED, __HIP_MEMORY_SCOPE_AGENT); }
          const v4u o0 = op[0], o1 = op[1]; float x[16], z[16];
#else
          const v4u o0 = op[0], o1 = op[1], z0 = zp[0], z1 = zp[1]; float x[16], z[16];
#endif
          x[0] = __uint_as_float(o0.x << 16); x[1] = __uint_as_float(o0.x & 0xffff0000u); x[2] = __uint_as_float(o0.y << 16); x[3] = __uint_as_float(o0.y & 0xffff0000u);
          x[4] = __uint_as_float(o0.z << 16); x[5] = __uint_as_float(o0.z & 0xffff0000u); x[6] = __uint_as_float(o0.w << 16); x[7] = __uint_as_float(o0.w & 0xffff0000u);
          x[8] = __uint_as_float(o1.x << 16); x[9] = __uint_as_float(o1.x & 0xffff0000u); x[10] = __uint_as_float(o1.y << 16); x[11] = __uint_as_float(o1.y & 0xffff0000u);
          x[12] = __uint_as_float(o1.z << 16); x[13] = __uint_as_float(o1.z & 0xffff0000u); x[14] = __uint_as_float(o1.w << 16); x[15] = __uint_as_float(o1.w & 0xffff0000u);
          z[0] = __uint_as_float(z0.x << 16); z[1] = __uint_as_float(z0.x & 0xffff0000u); z[2] = __uint_as_float(z0.y << 16); z[3] = __uint_as_float(z0.y & 0xffff0000u);
          z[4] = __uint_as_float(z0.z << 16); z[5] = __uint_as_float(z0.z & 0xffff0000u); z[6] = __uint_as_float(z0.w << 16); z[7] = __uint_as_float(z0.w & 0xffff0000u);
          z[8] = __uint_as_float(z1.x << 16); z[9] = __uint_as_float(z1.x & 0xffff0000u); z[10] = __uint_as_float(z1.y << 16); z[11] = __uint_as_float(z1.y & 0xffff0000u);
          z[12] = __uint_as_float(z1.z << 16); z[13] = __uint_as_float(z1.z & 0xffff0000u); z[14] = __uint_as_float(z1.w << 16); z[15] = __uint_as_float(z1.w & 0xffff0000u);
#pragma unroll
          for (int e = 0; e < 16; ++e) { if (!(fabsf(x[e]) < 1e30f)) x[e] = 0.f; if (!(fabsf(z[e]) < 1e30f)) z[e] = 0.f; }
          float ss = 0.f;
#pragma unroll
          for (int e = 0; e < 16; ++e) ss += x[e] * x[e];
          ss += __shfl_xor(ss, 1); ss += __shfl_xor(ss, 2); ss += __shfl_xor(ss, 4);
          const float r = 1.0f / sqrtf(ss * (1.0f / 128.0f) + EPS);
#if defined(DIAG_W)
          { float mo = 0.f, mz = 0.f;
            for (int e = 0; e < 16; ++e) { mo = fmaxf(mo, fabsf(x[e])); mz = fmaxf(mz, fabsf(z[e])); }
            atomicMax((unsigned*)STATS - 131072 + 4013, __float_as_uint(mo)); atomicMax((unsigned*)STATS - 131072 + 4012, __float_as_uint(mz)); }
#endif
#pragma unroll
          for (int e = 0; e < 16; ++e) x[e] = x[e] * r * ng[e] * z[e];
          v4u w0, w1; w0.x = cvt_pk_bf16(x[0], x[1]); w0.y = cvt_pk_bf16(x[2], x[3]); w0.z = cvt_pk_bf16(x[4], x[5]); w0.w = cvt_pk_bf16(x[6], x[7]);
          w1.x = cvt_pk_bf16(x[8], x[9]); w1.y = cvt_pk_bf16(x[10], x[11]); w1.z = cvt_pk_bf16(x[12], x[13]); w1.w = cvt_pk_bf16(x[14], x[15]);
          zp[0] = w0; zp[1] = w1; }
    }
}

__device__ __forceinline__ void gmlp_phase(LAS unsigned char* L, bf16* Ua, const bf16* Va, const float* STATS, const float* ln_g, const float* ln_b, const float* w_s, const float* b_s, int tid, int nblk, int bid) {
    const int w = __builtin_amdgcn_readfirstlane(tid >> 6), lane = tid & 63, fr = lane & 15, fq = lane >> 4;
    LAS unsigned char* VT = L; LAS unsigned char* WL = L + 34816;
    for (int unit = bid; unit < 1024; unit += nblk) {
        const int g = unit & 7, nc = (unit >> 3) & 63, b = unit >> 9; const size_t tok0 = (size_t)b * SEQ + 128 * nc;
        __syncthreads();
#pragma unroll
        for (int k4 = 0; k4 < 4; ++k4) { const int idx = tid + 512 * k4, s = idx & 127, ch = idx >> 7;
            const v4u a = *(const v4u*)(Va + (tok0 + s) * 1024 + 128 * g + 8 * ch); const float mu = STATS[(tok0 + s) * 2], rstd = STATS[(tok0 + s) * 2 + 1];
            const f32x4 g0 = *(const f32x4*)(ln_g + 128 * g + 8 * ch), g1 = *(const f32x4*)(ln_g + 128 * g + 8 * ch + 4), b0 = *(const f32x4*)(ln_b + 128 * g + 8 * ch), b1 = *(const f32x4*)(ln_b + 128 * g + 8 * ch + 4);
            float x[8]; x[0] = __uint_as_float(a.x << 16); x[1] = __uint_as_float(a.x & 0xffff0000u); x[2] = __uint_as_float(a.y << 16); x[3] = __uint_as_float(a.y & 0xffff0000u);
            x[4] = __uint_as_float(a.z << 16); x[5] = __uint_as_float(a.z & 0xffff0000u); x[6] = __uint_as_float(a.w << 16); x[7] = __uint_as_float(a.w & 0xffff0000u);
            const float gg[8] = {g0.x, g0.y, g0.z, g0.w, g1.x, g1.y, g1.z, g1.w}, bb[8] = {b0.x, b0.y, b0.z, b0.w, b1.x, b1.y, b1.z, b1.w};
#pragma unroll
            for (int e = 0; e < 8; ++e) { const float v = (x[e] - mu) * rstd * gg[e] + bb[e]; *(LAS unsigned short*)(VT + (8 * ch + e) * 272 + s * 2) = (unsigned short)(cvt_pk_bf16(v, 0.f) & 0xffffu); } }
#pragma unroll
        for (int k8 = 0; k8 < 8; ++k8) { const int idx = tid + 512 * k8, t = idx >> 5, s4 = (idx & 31) * 4; const f32x4 wv = *(const f32x4*)(w_s + ((size_t)(g * 128 + t)) * 128 + s4);
            v2u o; o.x = cvt_pk_bf16(s4 <= t ? wv.x : 0.f, s4 + 1 <= t ? wv.y : 0.f); o.y = cvt_pk_bf16(s4 + 2 <= t ? wv.z : 0.f, s4 + 3 <= t ? wv.w : 0.f);
            *(LAS v2u*)(WL + t * 272 + s4 * 2) = o; }
        __syncthreads();
        bf16x8 af[4];
#pragma unroll
        for (int s = 0; s < 4; ++s) af[s] = *(const LAS bf16x8*)(VT + (16 * w + fr) * 272 + s * 64 + fq * 16);
#pragma unroll
        for (int tt = 0; tt < 8; ++tt) { f32x4 acc = (f32x4){0.f, 0.f, 0.f, 0.f};
#pragma unroll
            for (int s = 0; s < 4; ++s) if (s <= (tt >> 1)) { const bf16x8 bfr = *(const LAS bf16x8*)(WL + (16 * tt + fr) * 272 + s * 64 + fq * 16); acc = __builtin_amdgcn_mfma_f32_16x16x32_bf16(af[s], bfr, acc, 0, 0, 0); }
            const int t = 16 * tt + fr; const float bs = b_s[g * 128 + t];
            v2u* up = (v2u*)(Ua + (tok0 + t) * 1024 + 128 * g + 16 * w + 4 * fq); const v2u uv = *up;
            v2u o; o.x = cvt_pk_bf16(__uint_as_float(uv.x << 16) * (acc[0] + bs), __uint_as_float(uv.x & 0xffff0000u) * (acc[1] + bs));
            o.y = cvt_pk_bf16(__uint_as_float(uv.y << 16) * (acc[2] + bs), __uint_as_float(uv.y & 0xffff0000u) * (acc[3] + bs)); *up = o; }
    }
}

struct Args { const float* in[23]; float* out; unsigned char* ws; int ph_lo, ph_hi; };
__global__ void __launch_bounds__(512, 2) mega_fwd(Args args_unused) {
    extern __shared__ __attribute__((aligned(16))) unsigned char lds[];
    cg::grid_group grid = cg::this_grid();
    LAS unsigned char* L = (LAS unsigned char*)lds;
    const int tid = threadIdx.x, lane = tid & 63, wave = __builtin_amdgcn_readfirstlane(tid >> 6);
    const int G = gridDim.x, bid = blockIdx.x;
    const int vcu = (G % 8 == 0) ? (bid % 8) * (G / 8) + bid / 8 : bid;
    const int gw = vcu * 8 + wave, NGW = G * 8;
    typedef __attribute__((address_space(4))) const unsigned long long kargp_t;
    kargp_t* kp = (kargp_t*)__builtin_amdgcn_kernarg_segment_ptr();
    const unsigned long long phw = kp[25]; const int ph_lo = (int)(phw & 0xffffffffu), ph_hi = (int)(phw >> 32);
    const bool single = (ph_hi - ph_lo) > 1;
    for (int u = threadIdx.x; u < 16; u += 512) ((volatile LAS unsigned*)(L + LDS_BYTES - 64))[u] = 0u;
    __syncthreads();
    XcdBarrier xbar; xbar.bar = (unsigned*)(__attribute__((address_space(1))) unsigned*)kp[24]; xbar.x = 0; xbar.st = (volatile LAS unsigned*)(L + LDS_BYTES - 64);
    if (single) { grid.sync(); xbar = xcd_barrier_post((unsigned*)(__attribute__((address_space(1))) unsigned*)kp[24], (volatile LAS unsigned*)(L + LDS_BYTES - 64)); }
    int pc = 0;
#define IN(k) (ph_lo <= (k) && (k) < ph_hi)
#if defined(DOUBLE_BAR)
#define GSYNC() } { const bool cur_ = IN(pc); ++pc; if (cur_ && IN(pc)) { xcd_barrier(xbar); xcd_barrier(xbar); } } if (IN(pc)) {
#else
#define GSYNC() } { const bool cur_ = IN(pc); ++pc; if (cur_ && IN(pc)) xcd_barrier(xbar); } if (IN(pc)) {
#endif
#define GASQ __attribute__((address_space(1)))
#define INP(k) ((const float*)(GASQ const float*)kp[k])
#define outp_ ((float*)(GASQ float*)kp[23])
#define wsp_ ((unsigned char*)(GASQ unsigned char*)kp[24])
#define xin_ INP(0)
#define cvec INP(1)
#define w_ada INP(2)
#define b_ada INP(3)
#define norm1_g INP(4)
#define f1_in INP(5)
#define f1_out INP(6)
#define norm2_g INP(7)
#define w_in INP(8)
#define conv_w INP(9)
#define a_log INP(10)
#define dt_bias INP(11)
#define dn_norm_g INP(12)
#define gm_ln_g INP(13)
#define gm_ln_b INP(14)
#define gm_w_s INP(15)
#define gm_b_s INP(16)
#define w_branch INP(17)
#define w_out INP(18)
#define norm3_g INP(19)
#define f2_in INP(20)
#define f2_out INP(21)
#define final_g INP(22)
#define MOD ((float*)(wsp_ + WS_MOD))
#define GL ((float*)(wsp_ + WS_GL))
#define STATS ((float*)(wsp_ + WS_STATS))
#define Gd ((float*)(wsp_ + WS_G))
#define Bd ((float*)(wsp_ + WS_BETA))
#define Wst ((bf16*)(wsp_ + WS_W))
#define Wbr ((bf16*)(wsp_ + WS_WBR))
#define Wout ((bf16*)(wsp_ + WS_WOUT))
#define Hb ((bf16*)(wsp_ + WS_H))
#define Qs ((bf16*)(wsp_ + WS_Q))
#define Ks ((bf16*)(wsp_ + WS_K))
#define Vs ((bf16*)(wsp_ + WS_V))
#define Zs ((bf16*)(wsp_ + WS_Z))
#define WWs ((bf16*)(wsp_ + WS_WW))
#define QKs ((bf16*)(wsp_ + WS_QK))
#define TAIL ((bf16*)(wsp_ + WS_TAIL))
#define ACT ((bf16*)(wsp_ + WS_ACT))
#define W_in1 Wst
#define W_out1 (Wst + (size_t)2 * FF * D)
    LAS float* scr = (LAS float*)(L + wave * 16384);

    if (IN(pc)) {
    {
        LAS float* sc = (LAS float*)(L + 135168);
        for (int i = tid; i < 2048; i += 512) { const float v = cvec[i]; sc[i] = v / (1.0f + __expf(-v)); }
        __syncthreads();
        constexpr int I1 = 16 * 176, I2 = 44 * 32, I3 = 2 * 16 * 32, I4 = 16 * 32;
        for (int it = gw; it < I1 + I2 + I3 + I4; it += NGW) {
            int r = it;
            if (r < I1) { conv_ffn_in(f1_in, W_in1, r, scr, lane); continue; } r -= I1;
            if (r < I2) { conv_plain(f1_out, FF, D, W_out1, r, scr, lane); continue; } r -= I2;
            if (r < I3) { const int wsel = r >> 9; conv_plain(w_branch + (size_t)wsel * D * D, D, D, Wbr + (size_t)wsel * D * D, r & 511, scr, lane); continue; } r -= I3;
            conv_plain(w_out, D, D, Wout, r, scr, lane);
        }
        for (int gi = NGW - 1 - gw; gi < 144 * 16; gi += NGW) { const int cg = gi >> 4, kc = gi & 15, col = cg * 64 + lane; float a0 = 0.f, a1 = 0.f;
#pragma unroll 16
            for (int k = 64 * kc; k < 64 * kc + 64; ++k) { const float wv = w_ada[(size_t)k * NMOD + col]; a0 += sc[k] * wv; a1 += sc[1024 + k] * wv; }
            if (kc == 0) { const float bb = b_ada[col]; a0 += bb; a1 += bb; }
            atomicAdd(MOD + col, a0); atomicAdd(MOD + NMOD + col, a1); }
    }
    GSYNC();
    norm_rows<0>(xin_, norm1_g, MOD, 0 * D, 1 * D, Hb, gw, NGW, lane, nullptr, nullptr, nullptr, nullptr, nullptr);
    GSYNC();
#if !defined(SKIP_F1)
    { pg8::Gemm g{Hb, W_in1, M, 2 * FF, D}; pg8::StaticOrder S; S.init(M, 2 * FF, G, bid); pg8::EpiSwiglu E{ACT, FF};
      pg8::gemm_phase<pg8::EpiSwiglu, pg8::StaticOrder, true, true>(L, g, S, E); }
    GSYNC();
#endif
    { pg8::Gemm g{ACT, W_out1, M, D, FF}; pg8::StaticOrder S; S.init(M, D, G, bid); pg8::EpiResid E{xin_, outp_, MOD + 2 * D, NMOD, F1SCALE};
      pg8::gemm_phase<pg8::EpiResid, pg8::StaticOrder, true, true>(L, g, S, E); }
    GSYNC();
    {
        for (int it = gw; it < 16 * 256; it += NGW) conv_inproj(w_in, Wst, it, scr, lane);
        __syncthreads();
        LAS float* wabT = (LAS float*)L;
        for (int k = tid; k < 1024; k += 512) { const float* wp = w_in + (size_t)k * INW + 6144;
#pragma unroll
            for (int c4 = 0; c4 < 4; ++c4) { const f32x4 v = *(const f32x4*)(wp + 4 * c4); wabT[(4 * c4 + 0) * 1024 + k] = v.x; wabT[(4 * c4 + 1) * 1024 + k] = v.y; wabT[(4 * c4 + 2) * 1024 + k] = v.z; wabT[(4 * c4 + 3) * 1024 + k] = v.w; } }
        __syncthreads();
        norm_rows<1>(outp_, norm2_g, MOD, 3 * D, 4 * D, Hb, gw, NGW, lane, wabT, a_log, dt_bias, Gd, Bd);
        __syncthreads();
    }
    GSYNC();
#if !defined(SKIP_MIX)
    { pg8::Gemm g{Hb, Wst, M, 3072, D}; pg8::StaticOrder S; S.init(M, 3072, G, bid); pg8::EpiI1 E{Qs, (size_t)M * D, TAIL};
      pg8::gemm_phase<pg8::EpiI1, pg8::StaticOrder, true, true>(L, g, S, E); }
    GSYNC();
#if !defined(SKIP_DN)
#if defined(DIAG_W)
    for (int it = bid; it < 2048; it += G) { const int hw_ = tid >> 8, ht_ = tid & 255; const int unit = it * 2 + hw_, h_ = unit & 7, n_ = (unit >> 3) & 127, b_ = unit >> 10;
        zprobe(Vs, (size_t)b_ * SEQ + 64 * n_, h_, ht_, lane, (unsigned*)GL + 4020 - 65536); }
    GSYNC();
#endif
#if !defined(SKIP_P6B)
    dn_local_phase<2>(L, Qs, Ks, Vs, WWs, QKs, TAIL, Gd, Bd, GL, conv_w, tid, G, bid);
#endif
    GSYNC();
#if !defined(SKIP_SCAN)
    if (bid < 128) dn_scan_phase(L, Qs, Ks, Vs, WWs, QKs, GL, tid, bid);
    else {
        pg8::Gemm g{Hb, Wst + (size_t)7168 * D, M, D, D}; pg8::ZOrder S{G - 128, bid - 128}; pg8::EpiZ E{Zs};
        pg8::gemm_phase<pg8::EpiZ, pg8::ZOrder, true, true>(L, g, S, E); }
#endif
    GSYNC();
#endif
    { pg8::Gemm g{Hb, Wst + (size_t)3072 * D, M, 4096, D}; pg8::StaticOrder S; S.init(M, 4096, G, bid); pg8::EpiI2 E{Qs, Ks, WWs, QKs, Zs};
      pg8::gemm_phase<pg8::EpiI2, pg8::StaticOrder, true, true>(L, g, S, E); }
    GSYNC();
    post_rows(Ks, STATS, Vs, Zs, dn_norm_g, gw, NGW, lane);
    GSYNC();
#if !defined(SKIP_GM)
    gmlp_phase(L, Qs, Ks, STATS, gm_ln_g, gm_ln_b, gm_w_s, gm_b_s, tid, G, bid);
    GSYNC();
#endif
    { pg8::Gemm g{Qs, Wbr, M, D, D}; pg8::BranchOrder S; S.so.init(M, D, G, bid); pg8::EpiBranch E{WWs, QKs, Hb};
      pg8::gemm_phase<pg8::EpiBranch, pg8::BranchOrder, true, true>(L, g, S, E); }
    GSYNC();
    { pg8::Gemm g{Hb, Wout, M, D, D}; pg8::StaticOrder S; S.init(M, D, G, bid); pg8::EpiResid E{outp_, outp_, MOD + 5 * D, NMOD, 1.0f};
      pg8::gemm_phase<pg8::EpiResid, pg8::StaticOrder, true, true>(L, g, S, E); }
    GSYNC();
#endif
    {
        constexpr int I1 = 16 * 176, I2 = 44 * 32;
        for (int it = gw; it < I1 + I2; it += NGW) { if (it < I1) conv_ffn_in(f2_in, W_in1, it, scr, lane); else conv_plain(f2_out, FF, D, W_out1, it - I1, scr, lane); }
        norm_rows<0>(outp_, norm3_g, MOD, 6 * D, 7 * D, Hb, gw, NGW, lane, nullptr, nullptr, nullptr, nullptr, nullptr);
    }
    GSYNC();
#if !defined(SKIP_F2)
    { pg8::Gemm g{Hb, W_in1, M, 2 * FF, D}; pg8::StaticOrder S; S.init(M, 2 * FF, G, bid); pg8::EpiSwiglu E{ACT, FF};
      pg8::gemm_phase<pg8::EpiSwiglu, pg8::StaticOrder, true, true>(L, g, S, E); }
    GSYNC();
    { pg8::Gemm g{ACT, W_out1, M, D, FF}; pg8::StaticOrder S; S.init(M, D, G, bid); pg8::EpiResid E{outp_, outp_, MOD + 8 * D, NMOD, 0.5f};
      pg8::gemm_phase<pg8::EpiResid, pg8::StaticOrder, true, true>(L, g, S, E); }
    GSYNC();
#endif
    {
        f32x4 fg[4];
#pragma unroll
        for (int j = 0; j < 4; ++j) fg[j] = *(const f32x4*)(final_g + 4 * lane + 256 * j);
        for (int m = gw; m < M; m += NGW) { f32x4* xr = (f32x4*)(outp_ + (size_t)m * D) + lane; f32x4 v[4]; float ss = 0.f;
#pragma unroll
            for (int j = 0; j < 4; ++j) { v[j] = xr[64 * j];
#if defined(NANGUARD)
                for (int e = 0; e < 4; ++e) if (!(fabsf(v[j][e]) < 1e30f)) v[j][e] = 0.f;
#endif
                ss += (v[j].x * v[j].x + v[j].y * v[j].y) + (v[j].z * v[j].z + v[j].w * v[j].w); }
            const float r = 1.0f / sqrtf(wave_sum(ss) * (1.0f / D) + EPS);
#pragma unroll
            for (int j = 0; j < 4; ++j) xr[64 * j] = v[j] * r * fg[j];
#if defined(OUT_TAIL)
            if (m < 768) { for (int j = 0; j < 4; ++j) { const bf16* tp = TAIL + (size_t)m * 3072 + OUT_TAIL_OFF + 4 * lane + 256 * j; xr[64 * j] = (f32x4){bf2f(tp[0]), bf2f(tp[1]), bf2f(tp[2]), bf2f(tp[3])}; } }
#endif
#if defined(DIAG_W)
            { float dv = __uint_as_float(((const unsigned*)wsp_)[4000 + (m < 8192 ? DIAG_SEL : DIAG_SEL2)]); if ((m < 8192 ? DIAG_SEL : DIAG_SEL2) == 9 || (m < 8192 ? DIAG_SEL : DIAG_SEL2) == 10) dv = (float)((const unsigned*)wsp_)[4000 + (m < 8192 ? DIAG_SEL : DIAG_SEL2)]; dv = fminf(fmaxf(10.f + log2f(fmaxf(dv, 1e-30f)), 0.f), 60.f);
              for (int j = 0; j < 4; ++j) xr[64 * j] = (f32x4){dv, dv, dv, dv}; }
#endif
            }
    }
}
}
#undef GSYNC
#undef IN
#undef INP
#undef outp_
#undef wsp_
#undef xin_
#undef cvec
#undef w_ada
#undef b_ada
#undef norm1_g
#undef f1_in
#undef f1_out
#undef norm2_g
#undef w_in
#undef conv_w
#undef a_log
#undef dt_bias
#undef dn_norm_g
#undef gm_ln_g
#undef gm_ln_b
#undef gm_w_s
#undef gm_b_s
#undef w_branch
#undef w_out
#undef norm3_g
#undef f2_in
#undef f2_out
#undef final_g
#undef MOD
#undef GL
#undef STATS
#undef Gd
#undef Bd
#undef Wst
#undef Wbr
#undef Wout
#undef Hb
#undef Qs
#undef Ks
#undef Vs
#undef Zs
#undef WWs
#undef QKs
#undef TAIL
#undef ACT
#undef W_in1
#undef W_out1
extern "C" void kernel_launch(void* const* d_in, const int* in_sizes, int n_in, void* d_out, int out_size, void* d_ws, size_t ws_size, hipStream_t stream) {
    static int grid = 0;
    if (grid == 0) {
        if (n_in != 23 || out_size != M * D || ws_size < WS_END) { fprintf(stderr, "kernel_launch: unexpected shapes (n_in %d, out %d, ws %zu)\n", n_in, out_size, ws_size); grid = -1; return; }
        int dev = 0, cus = 0, per_cu = 0;
        hipGetDevice(&dev); hipDeviceGetAttribute(&cus, hipDeviceAttributeMultiprocessorCount, dev);
        if (hipFuncSetAttribute((const void*)mega_fwd, hipFuncAttributeMaxDynamicSharedMemorySize, LDS_BYTES) != hipSuccess) { fprintf(stderr, "kernel_launch: hipFuncSetAttribute failed\n"); grid = -1; return; }
        if (hipOccupancyMaxActiveBlocksPerMultiprocessor(&per_cu, (const void*)mega_fwd, 512, LDS_BYTES) != hipSuccess || per_cu < 1) { fprintf(stderr, "kernel_launch: occupancy query says %d\n", per_cu); per_cu = 1; }
        (void)hipGetLastError();
        grid = cus;
        fprintf(stderr, "kernel_launch: cus %d per_cu %d grid %d\n", cus, per_cu, grid);
    }
    if (grid < 0) return;
    if (hipMemsetAsync(d_ws, 0, 262144, stream) != hipSuccess) { fprintf(stderr, "kernel_launch: memset failed\n"); return; }
    Args a{};
    for (int i = 0; i < 23; ++i) a.in[i] = (const float*)d_in[i];
    a.out = (float*)d_out; a.ws = (unsigned char*)d_ws;
#if defined(LAUNCH_PER_PHASE)
    for (int ph = 0; ph < 18; ++ph) { a.ph_lo = ph; a.ph_hi = ph + 1; hipLaunchKernelGGL(mega_fwd, dim3(grid), dim3(512), LDS_BYTES, stream, a); }
    hipError_t e = hipPeekAtLastError();
#else
    a.ph_lo = 0; a.ph_hi = 18;
    void* kargs[] = {&a};
    hipError_t e = hipLaunchCooperativeKernel((const void*)mega_fwd, dim3(grid), dim3(512), kargs, LDS_BYTES, stream);
#endif
    if (e != hipSuccess) fprintf(stderr, "kernel_launch: cooperative launch failed: %s (grid %d)\n", hipGetErrorString(e), grid);
}
```
